# Optimizing an MI355X kernel written in HIP

```python
import math
import jax, jax.numpy as jnp
from jax import lax
import numpy as np


D_MODEL = 2048
BATCH = 4
SEQ = 4096
DEPTH = 4

CHUNK = 64
Q_BLOCK = 128
D_FF = 5504
EPS = 1e-6

HG_HEADS = 6
HG_DK = 128
HG_DV = 128
HG_QK = HG_HEADS * HG_DK
HG_WIDTH = HG_HEADS * HG_DV
DF_HEADS = 4
DF_DQK = 64
DF_DV = 2 * DF_DQK
DF_QK = DF_HEADS * 2 * DF_DQK
DF_WIDTH = DF_HEADS * DF_DV
ML_HEADS = 6
ML_Q_RANK = 512
ML_KV_RANK = 256
ML_NOPE = 128
ML_ROPE = 64
ML_DV = 128
ML_WIDTH = ML_HEADS * ML_DV
ROPE_BASE = 10000.0
REL_BUCKETS = 32
REL_MAX_DIST = 128

D_MIX = HG_WIDTH + DF_WIDTH + ML_WIDTH

kernel_name = 'hybrid_hgrn2_diffattn_mla_macaron'


def _in_sizes():
    return (HG_QK, HG_QK, HG_WIDTH, HG_WIDTH,
            DF_QK, DF_QK, DF_WIDTH,
            ML_Q_RANK, ML_KV_RANK, ML_ROPE)


def _rms(x, g):
    xf = x.astype(jnp.float32)
    y = xf * lax.rsqrt(jnp.mean(xf * xf, axis=-1, keepdims=True) + EPS)
    return (y * g.astype(jnp.float32)).astype(x.dtype)


def _swiglu(h, w_gate, w_up, w_down):
    return (jax.nn.silu(h @ w_gate) * (h @ w_up)) @ w_down


def _chunk_mask(q_pos, k_pos):
    return (k_pos[None, :] // CHUNK) <= (q_pos[:, None] // CHUNK)


def _query_blocks(a):
    b, h, s, d = a.shape
    return a.reshape(b, h, s // Q_BLOCK, Q_BLOCK, d).transpose(2, 0, 1, 3, 4)


def _merge_blocks(o):
    n, b, h, qb, d = o.shape
    return o.transpose(1, 2, 0, 3, 4).reshape(b, h, n * qb, d)


def _t5_bucket(rel):
    half = REL_BUCKETS // 2
    max_exact = half // 2
    ret = (rel > 0).astype(jnp.int32) * half
    n = jnp.abs(rel)
    large = max_exact + (jnp.log(jnp.maximum(n, 1).astype(jnp.float32) / max_exact)
                         / math.log(REL_MAX_DIST / max_exact) * (half - max_exact)).astype(jnp.int32)
    large = jnp.minimum(large, half - 1)
    return ret + jnp.where(n < max_exact, n, large)


def _rope(x, pos):
    r = x.shape[-1]
    freqs = ROPE_BASE ** (-jnp.arange(0, r, 2, dtype=jnp.float32) / r)
    ang = pos.astype(jnp.float32)[:, None] * freqs[None, :]
    cos = jnp.cos(ang)[:, None, :]
    sin = jnp.sin(ang)[:, None, :]
    xf = x.astype(jnp.float32)
    x1, x2 = xf[..., : r // 2], xf[..., r // 2:]
    return jnp.concatenate([x1 * cos - x2 * sin, x2 * cos + x1 * sin], axis=-1).astype(x.dtype)


def _hgrn2(q, f_logit, i, g, lb, o_gain):
    b, s, _ = q.shape
    nc = s // CHUNK

    def heads_chunks(a, d):
        return a.reshape(b, nc, CHUNK, HG_HEADS, d).transpose(1, 0, 3, 2, 4).astype(jnp.float32)

    lbh = lb.astype(jnp.float32).reshape(HG_HEADS, 1, HG_DK)
    f = lbh + (1.0 - lbh) * jax.nn.sigmoid(heads_chunks(f_logit, HG_DK))
    log_f = jnp.log(f)
    k = 1.0 - f
    qc = heads_chunks(q, HG_DK) * (HG_DK ** -0.5)
    vc = heads_chunks(i, HG_DV)
    causal = jnp.tril(jnp.ones((CHUNK, CHUNK), dtype=bool))

    def step(state, inp):
        qt, kt, vt, lf = inp
        cum = jnp.cumsum(lf, axis=-2)
        o_inter = jnp.einsum('bhtk,bhkv->bhtv', qt * jnp.exp(cum), state)
        rel = cum[..., :, None, :] - cum[..., None, :, :]
        decay = jnp.exp(jnp.where(causal[:, :, None], rel, -jnp.inf))
        scores = jnp.einsum('bhtk,bhsk,bhtsk->bhts', qt, kt, decay)
        o = o_inter + jnp.einsum('bhts,bhsv->bhtv', scores, vt)
        last = cum[..., -1:, :]
        k_dec = kt * jnp.exp(last - cum)
        state = jnp.exp(last[..., 0, :])[..., None] * state + jnp.einsum('bhsk,bhsv->bhkv', k_dec, vt)
        return state, o

    s0 = jnp.zeros((b, HG_HEADS, HG_DK, HG_DV), jnp.float32)
    _, o = lax.scan(step, s0, (qc, k, vc, log_f))
    o = o.transpose(1, 0, 3, 2, 4).reshape(b, s, HG_HEADS, HG_DV)
    gh = g.reshape(b, s, HG_HEADS, HG_DV).astype(jnp.float32)
    o = _rms(o, o_gain) * jax.nn.silu(gh)
    return o.reshape(b, s, HG_WIDTH).astype(q.dtype)


def _diff_attn(q, k, v, q_gain, k_gain, lam, lambda_init, subln, rel_bias):
    b, s, _ = q.shape
    qh = _rms(q.reshape(b, s, DF_HEADS, 2, DF_DQK), q_gain).transpose(3, 0, 2, 1, 4)
    kh = _rms(k.reshape(b, s, DF_HEADS, 2, DF_DQK), k_gain).transpose(3, 0, 2, 1, 4)
    vh = v.reshape(b, s, DF_HEADS, DF_DV).transpose(0, 2, 1, 3)
    k1, k2 = kh[0], kh[1]
    k_pos = jnp.arange(s)
    scale = DF_DQK ** -0.5
    table = rel_bias.astype(jnp.float32)

    def blk(args):
        idx, a1, a2 = args
        q_pos = idx * Q_BLOCK + jnp.arange(Q_BLOCK)
        mask = _chunk_mask(q_pos, k_pos)
        bias = table[_t5_bucket(k_pos[None, :] - q_pos[:, None])].transpose(2, 0, 1)

        def probs(a, kk):
            logits = jnp.einsum('bhqd,bhkd->bhqk', a, kk).astype(jnp.float32) * scale + bias
            return jax.nn.softmax(jnp.where(mask, logits, -jnp.inf), axis=-1)

        w = probs(a1, k1) - lam * probs(a2, k2)
        return jnp.einsum('bhqk,bhkd->bhqd', w.astype(vh.dtype), vh)

    nqb = s // Q_BLOCK
    o = _merge_blocks(lax.map(blk, (jnp.arange(nqb), _query_blocks(qh[0]), _query_blocks(qh[1]))))
    o = _rms(o, subln) * (1.0 - lambda_init)
    return o.transpose(0, 2, 1, 3).reshape(b, s, DF_WIDTH).astype(q.dtype)


def _mla(c_q, c_kv, k_rope, q_lora_norm, w_uq, kv_lora_norm, w_ukv, q_gain, k_gain):
    b, s, _ = c_q.shape
    pos = jnp.arange(s)
    q = (_rms(c_q, q_lora_norm) @ w_uq).reshape(b, s, ML_HEADS, ML_NOPE + ML_ROPE)
    kv = (_rms(c_kv, kv_lora_norm) @ w_ukv).reshape(b, s, ML_HEADS, ML_NOPE + ML_DV)
    k_nope, v = kv[..., :ML_NOPE], kv[..., ML_NOPE:]
    k = jnp.concatenate([k_nope, jnp.broadcast_to(k_rope[:, :, None, :], (b, s, ML_HEADS, ML_ROPE))], axis=-1)
    q = _rms(q, q_gain)
    k = _rms(k, k_gain)
    q = jnp.concatenate([q[..., :ML_NOPE], _rope(q[..., ML_NOPE:], pos)], axis=-1).transpose(0, 2, 1, 3)
    k = jnp.concatenate([k[..., :ML_NOPE], _rope(k[..., ML_NOPE:], pos)], axis=-1).transpose(0, 2, 1, 3)
    v = v.transpose(0, 2, 1, 3)
    scale = (ML_NOPE + ML_ROPE) ** -0.5

    def blk(args):
        idx, qb = args
        q_pos = idx * Q_BLOCK + jnp.arange(Q_BLOCK)
        mask = _chunk_mask(q_pos, pos)
        logits = jnp.einsum('bhqd,bhkd->bhqk', qb, k).astype(jnp.float32) * scale
        p = jax.nn.softmax(jnp.where(mask, logits, -jnp.inf), axis=-1)
        return jnp.einsum('bhqk,bhkd->bhqd', p.astype(v.dtype), v)

    o = _merge_blocks(lax.map(blk, (jnp.arange(s // Q_BLOCK), _query_blocks(q))))
    return o.transpose(0, 2, 1, 3).reshape(b, s, ML_WIDTH).astype(c_q.dtype)


def setup_inputs(seed: int = 0) -> dict:
    key = jax.random.key(seed)
    ks = iter(jax.random.split(key, 40))
    L, D, F = DEPTH, D_MODEL, D_FF
    p_in = sum(_in_sizes())

    def w(shape, fan_in):
        return jax.random.normal(next(ks), shape, jnp.float32) * fan_in ** -0.5

    def gain(shape):
        return 1.0 + 0.02 * jax.random.normal(next(ks), shape, jnp.float32)

    def small(shape, sc):
        return sc * jax.random.normal(next(ks), shape, jnp.float32)

    return {
        'x': jax.random.normal(next(ks), (BATCH, SEQ, D), jnp.float32),
        'ffn_a_norm': gain((L, D)),
        'ffn_a_w_gate': w((L, D, F), D),
        'ffn_a_w_up': w((L, D, F), D),
        'ffn_a_w_down': w((L, F, D), F),
        'mix_norm': gain((L, D)),
        'w_in': w((L, D, p_in), D),
        'w_out': w((L, D_MIX, D), D_MIX),
        'hgrn_lb_logits': small((L, HG_QK), 1.0),
        'hgrn_out_norm': gain((L, HG_DV)),
        'diff_q_norm': gain((L, DF_DQK)),
        'diff_k_norm': gain((L, DF_DQK)),
        'diff_lambda_q1': small((L, DF_DQK), 0.1),
        'diff_lambda_k1': small((L, DF_DQK), 0.1),
        'diff_lambda_q2': small((L, DF_DQK), 0.1),
        'diff_lambda_k2': small((L, DF_DQK), 0.1),
        'diff_subln': gain((L, DF_DV)),
        'rel_bias': small((REL_BUCKETS, DF_HEADS), 0.5),
        'mla_q_lora_norm': gain((L, ML_Q_RANK)),
        'mla_w_uq': w((L, ML_Q_RANK, ML_HEADS * (ML_NOPE + ML_ROPE)), ML_Q_RANK),
        'mla_kv_lora_norm': gain((L, ML_KV_RANK)),
        'mla_w_ukv': w((L, ML_KV_RANK, ML_HEADS * (ML_NOPE + ML_DV)), ML_KV_RANK),
        'mla_q_norm': gain((L, ML_NOPE + ML_ROPE)),
        'mla_k_norm': gain((L, ML_NOPE + ML_ROPE)),
        'ffn_b_norm': gain((L, D)),
        'ffn_b_w_gate': w((L, D, F), D),
        'ffn_b_w_up': w((L, D, F), D),
        'ffn_b_w_down': w((L, F, D), F),
    }


def reference(x, ffn_a_norm, ffn_a_w_gate, ffn_a_w_up, ffn_a_w_down, mix_norm, w_in, w_out,
              hgrn_lb_logits, hgrn_out_norm, diff_q_norm, diff_k_norm, diff_lambda_q1, diff_lambda_k1,
              diff_lambda_q2, diff_lambda_k2, diff_subln, rel_bias, mla_q_lora_norm, mla_w_uq,
              mla_kv_lora_norm, mla_w_ukv, mla_q_norm, mla_k_norm, ffn_b_norm, ffn_b_w_gate,
              ffn_b_w_up, ffn_b_w_down):
    lb_all = jnp.cumsum(jax.nn.softmax(hgrn_lb_logits.astype(jnp.float32), axis=0), axis=0)
    lb_all = lb_all - lb_all[0:1]
    sizes = _in_sizes()
    offs = [0]
    for sz in sizes:
        offs.append(offs[-1] + sz)

    for l in range(DEPTH):
        x = x + 0.5 * _swiglu(_rms(x, ffn_a_norm[l]), ffn_a_w_gate[l], ffn_a_w_up[l], ffn_a_w_down[l])
        proj = _rms(x, mix_norm[l]) @ w_in[l]
        p = [proj[..., offs[j]:offs[j + 1]] for j in range(len(sizes))]
        o_hg = _hgrn2(p[0], p[1], p[2], p[3], lb_all[l], hgrn_out_norm[l])
        lambda_init = 0.8 - 0.6 * math.exp(-0.3 * l)
        lam = (jnp.exp(jnp.sum(diff_lambda_q1[l].astype(jnp.float32) * diff_lambda_k1[l].astype(jnp.float32)))
               - jnp.exp(jnp.sum(diff_lambda_q2[l].astype(jnp.float32) * diff_lambda_k2[l].astype(jnp.float32)))
               + lambda_init)
        o_df = _diff_attn(p[4], p[5], p[6], diff_q_norm[l], diff_k_norm[l], lam, lambda_init,
                          diff_subln[l], rel_bias)
        o_ml = _mla(p[7], p[8], p[9], mla_q_lora_norm[l], mla_w_uq[l], mla_kv_lora_norm[l],
                    mla_w_ukv[l], mla_q_norm[l], mla_k_norm[l])
        x = x + (jnp.concatenate([o_hg, o_df, o_ml], axis=-1) @ w_out[l]).astype(x.dtype)
        x = x + 0.5 * _swiglu(_rms(x, ffn_b_norm[l]), ffn_b_w_gate[l], ffn_b_w_up[l], ffn_b_w_down[l])
    return x
```

```cpp
#include <hip/hip_runtime.h>
#include <cstdio>
#include <cstdint>
__device__ __forceinline__ int ltid() { int t = (int)threadIdx.x; asm volatile("" : "+v"(t)); return t; }
namespace pg8 {
#define PG8_LAS __attribute__((address_space(3)))
typedef unsigned short bf16_t;
typedef short bf16x8 __attribute__((ext_vector_type(8)));
typedef float f32x4 __attribute__((ext_vector_type(4)));
typedef unsigned u32x4 __attribute__((ext_vector_type(4)));
constexpr int BM = 256, BK = 64, HALF = 128, HTB = HALF * BK * 2  , STAGE_BYTES = 8 * HTB, NXCD = 8, WGM = 8;

__host__ __device__ __forceinline__ int lds_byte(int r, int c) { const int st = (r >> 4) * 2 + (c >> 5), rr = r & 15, cc = c & 31, ob = rr * 64 + cc * 2; return st * 1024 + (ob ^ (((ob >> 9) & 1) << 5)); }
__host__ __device__ __forceinline__ void stage_rc(int b, int& R, int& C) { const int st = b / 1024, sb = b % 1024, swz = sb ^ (((sb >> 9) & 1) << 5); R = (st >> 1) * 16 + swz / 64; C = (st & 1) * 32 + (swz % 64) / 2; }
__host__ __device__ __forceinline__ int perm32(int rho) { const int n = rho >> 4, i = rho & 15; return 8 * (i >> 2) + 4 * n + (i & 3); }

struct Unit { int pm, pn; };
struct Gemm { const bf16_t* A; const bf16_t* Bt; int M, N, K; };

struct StaticOrder {
    int nM, nN, nwg, G, c;
    __host__ __device__ void init(int M, int N, int G_, int c_) { nM = M / BM; nN = N / BM; nwg = nM * nN; G = G_; c = c_; }
    __host__ __device__ bool next(int i, Unit& u) const {
        const long L = (long)i * G + c; if (L >= nwg) return false;
        int wgid = (int)L; { const int q = nwg / NXCD, r = nwg % NXCD, xcd = wgid % NXCD, off = wgid / NXCD; wgid = (xcd < r ? xcd * (q + 1) : r * (q + 1) + (xcd - r) * q) + off; }
        const int nig = WGM * nN, gid = wgid / nig, fm = gid * WGM, gsz = (nM - fm) < WGM ? (nM - fm) : WGM;
        u.pm = fm + ((wgid % nig) % gsz); u.pn = (wgid % nig) / gsz; return true;
    }
    __device__ __forceinline__ void a_ready(const Unit&) const {}
    __device__ __forceinline__ void done(const Unit&) const {}
};

__device__ __forceinline__ unsigned cvt_pk_bf16(float lo, float hi) { unsigned r; asm volatile("v_cvt_pk_bf16_f32 %0, %1, %2" : "=v"(r) : "v"(lo), "v"(hi)); return r; }
template <class Epi, class Sched, bool ALIGN_EPI = false, bool SP2 = false>
__device__ __forceinline__ void gemm_phase(PG8_LAS unsigned char* lds, const Gemm g, const Sched& S, const Epi& E) {
    const int tid = ltid(), wid = __builtin_amdgcn_readfirstlane(tid >> 6), lane = tid & 63, wr = wid >> 2, wc = wid & 3, fr = lane & 15, fq = lane >> 4;
    const int K = g.K, nt = K / BK;
    unsigned voffA[2], voffB[2];
#pragma unroll
    for (int i = 0; i < 2; ++i) { int R, C; stage_rc(tid * 16 + i * 8192, R, C); const int Rb = Epi::PERM ? ((R & ~31) + perm32(R & 31)) : R;
        voffA[i] = (unsigned)(R * K + C) * 2u; voffB[i] = (unsigned)(Rb * K + C) * 2u; }
    const size_t kstep = (size_t)(BK * 2);
    const size_t hstep = (size_t)HALF * K * 2;
    const size_t tstep = 2 * hstep;
    const unsigned ldsw = (unsigned)wid * 1024u;
    const int aoff = lds_byte(wr * 64 + fr, fq * 8), boff = lds_byte(wc * 32 + fr, fq * 8);
#define PG8_SA(b, h) (((b) * 2 + (h)) * HTB)
#define PG8_SB(b, h) ((4 + (b) * 2 + (h)) * HTB)
#define PG8_STAGE(bufoff, gbase, voff) do { _Pragma("unroll") for (int _i = 0; _i < 2; ++_i) \
        __builtin_amdgcn_global_load_lds((const unsigned*)((const char*)(gbase) + (voff)[_i]), (PG8_LAS unsigned*)(lds + (bufoff) + ldsw + _i * 8192), 16, 0, 0); } while (0)
#define PG8_LDA(dst, b, h) do { _Pragma("unroll") for (int m = 0; m < 4; ++m) _Pragma("unroll") for (int k = 0; k < 2; ++k) dst[m][k] = *(const PG8_LAS bf16x8*)(lds + PG8_SA(b, h) + aoff + m * 2048 + k * 1024); } while (0)
#define PG8_LDB(dst, b, h) do { _Pragma("unroll") for (int n = 0; n < 2; ++n) _Pragma("unroll") for (int k = 0; k < 2; ++k) dst[n][k] = *(const PG8_LAS bf16x8*)(lds + PG8_SB(b, h) + boff + n * 2048 + k * 1024); } while (0)
#define PG8_MMA(ai, bj, At, Bt) do { __builtin_amdgcn_s_setprio(1); _Pragma("unroll") for (int m = 0; m < 4; ++m) _Pragma("unroll") for (int n = 0; n < 2; ++n) _Pragma("unroll") for (int k = 0; k < 2; ++k) \
        acc[ai][bj][m][n] = __builtin_amdgcn_mfma_f32_16x16x32_bf16(Bt[n][k], At[m][k], acc[ai][bj][m][n], 0, 0, 0); __builtin_amdgcn_s_setprio(0); } while (0)
#define PG8_WAIT_V(n) asm volatile("s_waitcnt vmcnt(" #n ")" ::: "memory")
#define PG8_WAIT_L(n) asm volatile("s_waitcnt lgkmcnt(" #n ")" ::: "memory")
#define PG8_BAR __builtin_amdgcn_s_barrier()
#define PG8_SCHED __builtin_amdgcn_sched_barrier(0)
    Unit cur, nxt; int ui = 0;
    if (!S.next(0, cur)) return;
    f32x4 acc[2][2][4][2];
#pragma unroll
    for (int a = 0; a < 2; ++a)
#pragma unroll
        for (int b = 0; b < 2; ++b)
#pragma unroll
            for (int m = 0; m < 4; ++m)
#pragma unroll
                for (int n = 0; n < 2; ++n) acc[a][b][m][n] = (f32x4){0.f, 0.f, 0.f, 0.f};
    bf16x8 At[4][2], B0[2][2], B1[2][2];
    const char* cA = (const char*)g.A + (size_t)cur.pm * tstep; const char* cB = (const char*)g.Bt + (size_t)cur.pn * tstep;
    S.a_ready(cur);
    if constexpr (SP2) {
        PG8_STAGE(PG8_SB(0, 0), cB, voffB); PG8_STAGE(PG8_SB(0, 1), cB + hstep, voffB); PG8_STAGE(PG8_SA(0, 0), cA, voffA); PG8_STAGE(PG8_SA(0, 1), cA + hstep, voffA);
        if (wr == 1) PG8_BAR;
        PG8_WAIT_V(2); PG8_BAR;
        PG8_STAGE(PG8_SB(1, 0), cB + kstep, voffB); PG8_STAGE(PG8_SA(1, 0), cA + kstep, voffA); PG8_STAGE(PG8_SB(1, 1), cB + hstep + kstep, voffB);
        PG8_WAIT_V(6); PG8_BAR;
    } else {
        PG8_STAGE(PG8_SB(0, 0), cB, voffB); PG8_STAGE(PG8_SA(0, 0), cA, voffA); PG8_STAGE(PG8_SB(0, 1), cB + hstep, voffB); PG8_STAGE(PG8_SA(0, 1), cA + hstep, voffA);
        if (wr == 1) PG8_BAR;
        PG8_WAIT_V(4); PG8_BAR;
        PG8_STAGE(PG8_SB(1, 0), cB + kstep, voffB); PG8_STAGE(PG8_SA(1, 0), cA + kstep, voffA); PG8_STAGE(PG8_SB(1, 1), cB + hstep + kstep, voffB);
        PG8_WAIT_V(6); PG8_BAR;
    }
    for (;;) {
        const bool has_next = S.next(ui + 1, nxt);
        const char* nA = has_next ? (const char*)g.A + (size_t)nxt.pm * tstep : cA; const char* nB = has_next ? (const char*)g.Bt + (size_t)nxt.pn * tstep : cB;
        for (int t = 0; t < nt; t += 2) {
            const bool last = (t == nt - 2);
            const char* a1 = cA + (size_t)(t + 1) * kstep;
            const char* a2 = last ? nA : cA + (size_t)(t + 2) * kstep; const char* b2 = last ? nB : cB + (size_t)(t + 2) * kstep;
            const char* a3 = a2 + kstep; const char* b3 = b2 + kstep;
            if (last && has_next) S.a_ready(nxt);
            if constexpr (SP2) {
            PG8_LDB(B0, 0, 0); PG8_LDB(B1, 0, 1); PG8_SCHED; PG8_LDA(At, 0, 0); PG8_STAGE(PG8_SA(1, 1), a1 + hstep, voffA);
            PG8_WAIT_V(8); PG8_WAIT_L(0); PG8_BAR; PG8_MMA(0, 0, At, B0); PG8_MMA(0, 1, At, B1); PG8_BAR; PG8_SCHED;
            PG8_LDA(At, 0, 1); PG8_STAGE(PG8_SB(0, 0), b2, voffB); PG8_STAGE(PG8_SB(0, 1), b2 + hstep, voffB); PG8_STAGE(PG8_SA(0, 0), a2, voffA);
            PG8_WAIT_V(8); PG8_WAIT_L(0); PG8_BAR; PG8_MMA(1, 0, At, B0); PG8_MMA(1, 1, At, B1); PG8_BAR; PG8_SCHED;
            PG8_LDB(B0, 1, 0); PG8_LDB(B1, 1, 1); PG8_SCHED; PG8_LDA(At, 1, 0); PG8_STAGE(PG8_SA(0, 1), a2 + hstep, voffA);
            PG8_WAIT_V(8); PG8_WAIT_L(0); PG8_BAR; PG8_MMA(0, 0, At, B0); PG8_MMA(0, 1, At, B1); PG8_BAR; PG8_SCHED;
            PG8_LDA(At, 1, 1); PG8_STAGE(PG8_SB(1, 0), b3, voffB); PG8_STAGE(PG8_SB(1, 1), b3 + hstep, voffB); PG8_STAGE(PG8_SA(1, 0), a3, voffA);
            PG8_WAIT_V(8); PG8_WAIT_L(0); PG8_BAR; PG8_MMA(1, 0, At, B0); PG8_MMA(1, 1, At, B1); PG8_BAR; PG8_SCHED;
            } else {
            PG8_LDB(B0, 0, 0); PG8_SCHED; PG8_LDA(At, 0, 0); PG8_STAGE(PG8_SA(1, 1), a1 + hstep, voffA);
            PG8_WAIT_L(8); PG8_BAR; PG8_WAIT_L(0); PG8_MMA(0, 0, At, B0); PG8_BAR; PG8_SCHED;
            PG8_LDB(B1, 0, 1); PG8_STAGE(PG8_SB(0, 0), b2, voffB);
            PG8_BAR; PG8_WAIT_L(0); PG8_MMA(0, 1, At, B1); PG8_BAR;
            PG8_LDA(At, 0, 1); PG8_STAGE(PG8_SA(0, 0), a2, voffA);
            PG8_BAR; PG8_WAIT_L(0); PG8_MMA(1, 0, At, B0); PG8_BAR; PG8_SCHED;
            PG8_STAGE(PG8_SB(0, 1), b2 + hstep, voffB);
            PG8_WAIT_V(6); PG8_BAR; PG8_MMA(1, 1, At, B1); PG8_BAR;
            PG8_LDB(B0, 1, 0); PG8_SCHED; PG8_LDA(At, 1, 0); PG8_STAGE(PG8_SA(0, 1), a2 + hstep, voffA);
            PG8_WAIT_L(8); PG8_BAR; PG8_WAIT_L(0); PG8_MMA(0, 0, At, B0); PG8_BAR; PG8_SCHED;
            PG8_LDB(B1, 1, 1); PG8_STAGE(PG8_SB(1, 0), b3, voffB);
            PG8_BAR; PG8_WAIT_L(0); PG8_MMA(0, 1, At, B1); PG8_BAR;
            PG8_LDA(At, 1, 1); PG8_STAGE(PG8_SA(1, 0), a3, voffA);
            PG8_BAR; PG8_WAIT_L(0); PG8_MMA(1, 0, At, B0); PG8_BAR; PG8_SCHED;
            PG8_STAGE(PG8_SB(1, 1), b3 + hstep, voffB);
            PG8_WAIT_V(6); PG8_BAR; PG8_MMA(1, 1, At, B1); PG8_BAR;
            }
        }
        if constexpr (ALIGN_EPI) { if (wr == 0) PG8_BAR; }
        if constexpr (!Epi::AFTER_DRAIN) { E(acc, cur, wr, wc, fr, fq); S.done(cur); }
        if (!has_next) break;
#pragma unroll
        for (int a = 0; a < 2; ++a)
#pragma unroll
            for (int b = 0; b < 2; ++b)
#pragma unroll
                for (int m = 0; m < 4; ++m)
#pragma unroll
                    for (int n = 0; n < 2; ++n) acc[a][b][m][n] = (f32x4){0.f, 0.f, 0.f, 0.f};
        cur = nxt; cA = nA; cB = nB; ++ui;
        if constexpr (ALIGN_EPI) { if (wr == 1) PG8_BAR; }
    }
    PG8_WAIT_V(0);
    if constexpr (!ALIGN_EPI) { if (wr == 0) PG8_BAR; }
    PG8_BAR;
    if constexpr (Epi::AFTER_DRAIN) { E.fused(acc, cur, wr, wc, fr, fq, lds, wid, lane); S.done(cur); }
#undef PG8_SA
#undef PG8_SB
#undef PG8_STAGE
#undef PG8_LDA
#undef PG8_LDB
#undef PG8_MMA
#undef PG8_WAIT_V
#undef PG8_WAIT_L
#undef PG8_BAR
#undef PG8_SCHED
}
}
#define GAS __attribute__((address_space(1)))
#define LAS __attribute__((address_space(3)))
typedef unsigned short bf16;
typedef unsigned v4u __attribute__((ext_vector_type(4)));
typedef float f32x4 __attribute__((ext_vector_type(4)));
typedef short bf16x8 __attribute__((ext_vector_type(8)));
typedef GAS unsigned gu32;
typedef GAS unsigned long long gu64;
#define RLX_AGENT __ATOMIC_RELAXED, __HIP_MEMORY_SCOPE_AGENT
#define LDS_WAIT() asm volatile("s_waitcnt lgkmcnt(0)" ::: "memory")
#define VM_WAIT() asm volatile("s_waitcnt vmcnt(0)" ::: "memory")
__device__ __forceinline__ unsigned long long rt() { return __builtin_amdgcn_s_memrealtime(); }

#define XB_TMO      128
#define XB_XCNT(j)  (256  + 64 * (j))
#define XB_XSUB(j)  (1280 + 64 * (j))
#define XB_XGEN(j)  (2304 + 64 * (j))
#define XB_TOP      3328
#define XB_TOPGEN   3392
#define XCD_BAR_WORDS 3456
#define XB_SPIN_CAP (1u << 21)

__device__ __forceinline__ unsigned xb_ld(unsigned* p)              { return __hip_atomic_load(p, __ATOMIC_RELAXED, __HIP_MEMORY_SCOPE_AGENT); }
__device__ __forceinline__ unsigned xb_add(unsigned* p, unsigned v) { return __hip_atomic_fetch_add(p, v, __ATOMIC_RELAXED, __HIP_MEMORY_SCOPE_AGENT); }
__device__ __forceinline__ unsigned xb_xcc_id() { return (unsigned)__builtin_amdgcn_s_getreg((3 << 11) | 20) & 0xFu; }
#define XB_SPIN(cond, bar) do { unsigned _sp = 0; while (cond) { __builtin_amdgcn_s_sleep(1); \
    if ((++_sp & 255u) == 0u) { if (xb_ld(&(bar)[XB_TMO])) break; if (_sp > XB_SPIN_CAP) { atomicAdd(&(bar)[XB_TMO], 1u); break; } } } } while (0)

struct XcdBarrier {
    unsigned* bar; unsigned x;
    volatile LAS unsigned* st;
};

__device__ __forceinline__ XcdBarrier xcd_barrier_post(unsigned* bar, volatile LAS unsigned* st) {
    XcdBarrier b; b.bar = bar; b.x = xb_xcc_id(); b.st = st;
    if (threadIdx.x == 0) (void)xb_add(&bar[XB_XCNT(b.x)], 1u);
    return b;
}
__device__ __forceinline__ void xcd_barrier_complete(unsigned* bar, unsigned x, unsigned& nloc, unsigned& nx) {
    const unsigned G = gridDim.x * gridDim.y * gridDim.z;
    unsigned sum, cnt, mine, sp = 0u;
    for (;;) {
        sum = 0u; cnt = 0u; mine = 0u;
#pragma unroll
        for (unsigned j = 0; j < 16; ++j) { const unsigned c = xb_ld(&bar[XB_XCNT(j)]); sum += c; cnt += (c > 0u) ? 1u : 0u; mine = (j == x) ? c : mine; }
        if (sum == G) break;
        __builtin_amdgcn_s_sleep(1);
        if ((++sp & 255u) == 0u) { if (xb_ld(&bar[XB_TMO])) break; if (sp > XB_SPIN_CAP) { atomicAdd(&bar[XB_TMO], 1u); break; } }
    }
    nloc = mine > 0u ? mine : 1u; nx = cnt > 0u ? cnt : 1u;
}

__device__ __forceinline__ void xcd_barrier(const XcdBarrier& b) {
    asm volatile("s_waitcnt vmcnt(0)" ::: "memory");
    __syncthreads();
    if (threadIdx.x == 0) {
        unsigned* bar = b.bar;
        __builtin_amdgcn_s_waitcnt(0);
        unsigned nloc = b.st[0], nx = b.st[1];
        if (nloc == 0u) { xcd_barrier_complete(bar, b.x, nloc, nx); b.st[0] = nloc; b.st[1] = nx; }
        const unsigned old = xb_add(&bar[XB_XSUB(b.x)], 1u);
        const unsigned gen = old / nloc;
        if (old + 1u == (gen + 1u) * nloc) {
            __builtin_amdgcn_fence(__ATOMIC_RELEASE, "agent");
            asm volatile("s_waitcnt vmcnt(0)" ::: "memory");
            const unsigned og = xb_add(&bar[XB_TOP], 1u);
            const unsigned tg = og / nx;
            if (og + 1u == (tg + 1u) * nx) xb_add(&bar[XB_TOPGEN], 1u);
            else XB_SPIN(xb_ld(&bar[XB_TOPGEN]) == tg, bar);
            __builtin_amdgcn_fence(__ATOMIC_ACQUIRE, "agent");
            xb_add(&bar[XB_XGEN(b.x)], 1u);
            asm volatile("s_waitcnt vmcnt(0)" ::: "memory");
        } else {
            XB_SPIN(xb_ld(&bar[XB_XGEN(b.x)]) == gen, bar);
            __builtin_amdgcn_fence(__ATOMIC_ACQUIRE, "agent");
            asm volatile("s_waitcnt vmcnt(0)" ::: "memory");
        }
    }
    __syncthreads();
}

#define DI __device__ __forceinline__
typedef float f32x2 __attribute__((ext_vector_type(2)));
typedef __bf16 bf16x2_t __attribute__((ext_vector_type(2)));
typedef float f32x16 __attribute__((ext_vector_type(16)));
typedef short s16x4 __attribute__((ext_vector_type(4)));
constexpr int NWAVES = 8, NTHREADS = 512;
constexpr int BATCH = 4, SEQ = 4096, M = BATCH * SEQ, D = 2048, F = 5504, NGU = 2 * F, NL = 4;
constexpr int PIN = 5440, PINP = 5632;
constexpr int HGW = 768, UQN = 1152, UKVN = 1536;
constexpr float EPS = 1e-6f;
constexpr float LOG2E = 1.4426950408889634f;
constexpr int C_HQ = 0, C_HF = 768, C_HI = 1536, C_HG = 2304, C_DQ = 3072, C_DK = 3584, C_DV = 4096, C_CQ = 4608, C_CKV = 5120, C_KR = 5376;
constexpr int MX_HG = 0, MX_DF = 768, MX_ML = 1280;
constexpr float SC_HQ = 0.08838834764831845f;
constexpr float SC_DQ = 0.125f * LOG2E;
constexpr float SC_MQ = 0.07216878364870322f * LOG2E;

constexpr size_t MiB = 1u << 20;
constexpr size_t WS_CTL = 0, CTL_ZERO_BYTES = 1 * MiB;
constexpr size_t WS_CONST = 1 * MiB;
constexpr size_t CO_LB = 0, CO_LAM = 16384, CO_BIAS = 20480, CO_ROPE = 65536;
constexpr size_t WS_W = 4 * MiB;
constexpr size_t SZ_GU = (size_t)NGU * D * 2, SZ_DN = (size_t)D * F * 2, SZ_IN = (size_t)PINP * D * 2, SZ_OUT = (size_t)D * D * 2, SZ_UQ = (size_t)UQN * 512 * 2, SZ_UKV = (size_t)UKVN * 256 * 2;
constexpr size_t WO_GUA = 0, WO_DA = WO_GUA + SZ_GU, WO_IN = WO_DA + SZ_DN, WO_OUT = WO_IN + SZ_IN, WO_UQ = WO_OUT + SZ_OUT, WO_UKV = WO_UQ + SZ_UQ, WO_GUB = WO_UKV + SZ_UKV, WO_DB = WO_GUB + SZ_GU, W_LAYER = WO_DB + SZ_DN;
constexpr size_t WS_XB = WS_W + NL * W_LAYER;
constexpr size_t WS_STATS = WS_XB + (size_t)M * D * 2;
constexpr size_t WS_A = WS_STATS + (size_t)M * 32 * 4;
constexpr size_t WS_LF = WS_A + (size_t)M * PINP * 2;
constexpr size_t WS_QI = WS_LF + (size_t)M * HGW * 4;
constexpr size_t WS_P = WS_QI + (size_t)M * HGW * 2;
constexpr size_t WS_KDT = WS_P + (size_t)1536 * 4096 * 2;
constexpr size_t WS_VT = WS_KDT + (size_t)M * HGW * 2;
constexpr size_t WS_DEC = WS_VT + (size_t)M * HGW * 2;
constexpr size_t WS_QM = WS_DEC + 1 * MiB;
constexpr size_t WS_KM = WS_QM + (size_t)M * UQN * 2;
constexpr size_t WS_VM = WS_KM + (size_t)M * UQN * 2;
constexpr size_t WS_QN = WS_VM + (size_t)M * 768 * 2;
constexpr size_t WS_KN = WS_QN + (size_t)M * 512 * 2;
constexpr size_t WS_SCR = WS_KN + (size_t)M * 512 * 2;
constexpr size_t WS_MIX = WS_SCR + (size_t)256 * 256 * 128 * 4;
constexpr size_t WS_END = WS_MIX + (size_t)M * D * 2;
static_assert(WS_XB % 256 == 0 && WS_A % 256 == 0 && WS_QM % 256 == 0 && WS_MIX % 256 == 0, "ws map alignment");
constexpr int CW_BAR = 4096;
constexpr int CW_Q = 16384;

constexpr int RING_BYTES = 131072, LDSCTL_OFF = RING_BYTES, MISC_OFF = LDSCTL_OFF + 320, LDS_BYTES = 147456;

DI unsigned pk2(float lo, float hi) { f32x2 v = {lo, hi}; bf16x2_t b = __builtin_convertvector(v, bf16x2_t); return __builtin_bit_cast(unsigned, b); }
DI float bflo(unsigned w) { return __uint_as_float(w << 16); }
DI float bfhi(unsigned w) { return __uint_as_float(w & 0xffff0000u); }
DI float bf2f(unsigned short b) { return __uint_as_float(((unsigned)b) << 16); }
DI float wave_sum(float v) {
#pragma unroll
    for (int o = 1; o < 64; o <<= 1) v += __shfl_xor(v, o);
    return v;
}
DI float ex2(float x) { return __builtin_amdgcn_exp2f(x); }
DI float fexp(float x) { return __builtin_amdgcn_exp2f(x * LOG2E); }
DI float fsigmoid(float x) { return __builtin_amdgcn_rcpf(1.f + fexp(-x)); }
DI float frsqrt(float x) { return __builtin_amdgcn_rsqf(x); }
DI bf16x8 mk8(unsigned a, unsigned b, unsigned c, unsigned d) { v4u w = {a, b, c, d}; return __builtin_bit_cast(bf16x8, w); }
DI f32x4 mfma16(bf16x8 a, bf16x8 b, f32x4 c) { return __builtin_amdgcn_mfma_f32_16x16x32_bf16(a, b, c, 0, 0, 0); }

DI void load_rs(const float* stats, int row0, int fq, float (&rs)[2][4]) {
#pragma unroll
    for (int ai = 0; ai < 2; ++ai)
#pragma unroll
        for (int m = 0; m < 4; ++m) { const f32x4* p = (const f32x4*)(stats + (size_t)(row0 + ai * 128 + m * 16) * 32 + 8 * fq); const f32x4 a = p[0], b = p[1];
            float s = ((a[0] + a[1]) + (a[2] + a[3])) + ((b[0] + b[1]) + (b[2] + b[3])); s += __shfl_xor(s, 16); s += __shfl_xor(s, 32); rs[ai][m] = frsqrt(s * (1.0f / D) + EPS); }
}
struct EpiSwiGLU {
    static constexpr bool PERM = true, AFTER_DRAIN = false;
    bf16* H; const float* stats;
    DI void operator()(const pg8::f32x4 (&acc)[2][2][4][2], const pg8::Unit& u, int wr, int wc, int fr, int fq) const {
        const int row0 = u.pm * 256 + wr * 64 + fr, col0 = u.pn * 128 + wc * 32 + 8 * fq;
        float rs[2][4]; load_rs(stats, row0, fq, rs);
#pragma unroll
        for (int ai = 0; ai < 2; ++ai)
#pragma unroll
            for (int m = 0; m < 4; ++m) { const float r = rs[ai][m]; float hv[8];
#pragma unroll
                for (int n = 0; n < 2; ++n)
#pragma unroll
                    for (int j = 0; j < 4; ++j) { const float g = acc[ai][0][m][n][j] * r, up = acc[ai][1][m][n][j] * r; hv[4 * n + j] = g * fsigmoid(g) * up; }
                v4u w; w.x = pk2(hv[0], hv[1]); w.y = pk2(hv[2], hv[3]); w.z = pk2(hv[4], hv[5]); w.w = pk2(hv[6], hv[7]);
                *(v4u*)(H + (size_t)(row0 + ai * 128 + m * 16) * F + col0) = w; }
    }
};
struct EpiResid {
    static constexpr bool PERM = true, AFTER_DRAIN = false;
    float* X; bf16* XB; float* stats; float alpha;
    DI void operator()(const pg8::f32x4 (&acc)[2][2][4][2], const pg8::Unit& u, int wr, int wc, int fr, int fq) const {
        const int row0 = u.pm * 256 + wr * 64 + fr, col0 = u.pn * 256 + wc * 32 + 8 * fq;
#pragma unroll
        for (int ai = 0; ai < 2; ++ai)
#pragma unroll
            for (int m = 0; m < 4; ++m) { const int row = row0 + ai * 128 + m * 16; float ss = 0.f;
#pragma unroll
                for (int bj = 0; bj < 2; ++bj) { float* xp = X + (size_t)row * D + col0 + bj * 128;
                    f32x4 x0 = *(const f32x4*)xp, x1 = *(const f32x4*)(xp + 4);
                    x0 = x0 + acc[ai][bj][m][0] * alpha; x1 = x1 + acc[ai][bj][m][1] * alpha;
                    *(f32x4*)xp = x0; *(f32x4*)(xp + 4) = x1;
                    ss += (x0[0] * x0[0] + x0[1] * x0[1]) + (x0[2] * x0[2] + x0[3] * x0[3]) + (x1[0] * x1[0] + x1[1] * x1[1]) + (x1[2] * x1[2] + x1[3] * x1[3]);
                    v4u w; w.x = pk2(x0[0], x0[1]); w.y = pk2(x0[2], x0[3]); w.z = pk2(x1[0], x1[1]); w.w = pk2(x1[2], x1[3]);
                    *(v4u*)(XB + (size_t)row * D + col0 + bj * 128) = w; }
                ss += __shfl_xor(ss, 16); ss += __shfl_xor(ss, 32);
                if (fq == 0) stats[(size_t)row * 32 + u.pn * 4 + wc] = ss;
                asm volatile("" ::: "memory"); }
    }
};
struct EpiProj {
    static constexpr bool PERM = true, AFTER_DRAIN = false;
    bf16* P; float* LF; const float* stats; const float* lb;
    DI void operator()(const pg8::f32x4 (&acc)[2][2][4][2], const pg8::Unit& u, int wr, int wc, int fr, int fq) const {
        const int row0 = u.pm * 256 + wr * 64 + fr, col0 = u.pn * 256 + wc * 32 + 8 * fq;
        float rs[2][4]; load_rs(stats, row0, fq, rs);
        const int seg = u.pn < 3 ? 0 : (u.pn < 6 ? 1 : (u.pn < 9 ? 2 : (u.pn < 12 ? 3 : 4)));
#pragma unroll
        for (int bj = 0; bj < 2; ++bj) { const int col = col0 + bj * 128;
            float lbv[8];
            if (seg == 1) { const f32x4 a = *(const f32x4*)(lb + col - C_HF), b = *(const f32x4*)(lb + col - C_HF + 4); lbv[0] = a[0]; lbv[1] = a[1]; lbv[2] = a[2]; lbv[3] = a[3]; lbv[4] = b[0]; lbv[5] = b[1]; lbv[6] = b[2]; lbv[7] = b[3]; }
            else {
#pragma unroll
                for (int j = 0; j < 8; ++j) lbv[j] = 0.f; }
#pragma unroll
            for (int ai = 0; ai < 2; ++ai)
#pragma unroll
                for (int m = 0; m < 4; ++m) { const int row = row0 + ai * 128 + m * 16; const float r = rs[ai][m]; float v[8];
#pragma unroll
                    for (int n = 0; n < 2; ++n)
#pragma unroll
                        for (int j = 0; j < 4; ++j) v[4 * n + j] = acc[ai][bj][m][n][j] * r;
                    if (seg == 0) {
#pragma unroll
                        for (int j = 0; j < 8; ++j) v[j] *= SC_HQ; }
                    else if (seg == 1) { float lf[8];
#pragma unroll
                        for (int j = 0; j < 8; ++j) { const float f = lbv[j] + (1.f - lbv[j]) * fsigmoid(v[j]); lf[j] = __builtin_amdgcn_logf(f) * 0.6931471805599453f; v[j] = 1.f - f; }
                        float* lp = LF + (size_t)row * HGW + col - C_HF; *(f32x4*)lp = (f32x4){lf[0], lf[1], lf[2], lf[3]}; *(f32x4*)(lp + 4) = (f32x4){lf[4], lf[5], lf[6], lf[7]}; }
                    else if (seg == 3) {
#pragma unroll
                        for (int j = 0; j < 8; ++j) v[j] = v[j] * fsigmoid(v[j]); }
                    v4u w; w.x = pk2(v[0], v[1]); w.y = pk2(v[2], v[3]); w.z = pk2(v[4], v[5]); w.w = pk2(v[6], v[7]);
                    *(v4u*)(P + (size_t)row * PINP + col) = w; }
        }
    }
};

namespace att {
constexpr int KVBLK = 64, QBLK = 32, DV = 128;
constexpr int SHM_V = KVBLK * DV * 2;
constexpr float THR2 = 8.f * LOG2E;
template <int DQK> struct Cfg {
    static constexpr int KROW = DQK * 2 + 16, SHM_K = KVBLK * KROW, KCH = DQK / 64, CPR = DQK / 8;
    static constexpr int OFF_V = 0, OFF_K = 2 * SHM_V, OFF_WS = OFF_K + 2 * SHM_K, OFF_BIAS = OFF_WS + NWAVES * 64 * 4, BYTES = OFF_BIAS + 1024;
};
static_assert(Cfg<192>::BYTES <= RING_BYTES, "attention LDS");
#define SBAR() __builtin_amdgcn_sched_barrier(0)
DI int crow(int r, int hi) { return (r & 3) + 8 * (r >> 2) + 4 * hi; }
DI unsigned cvtpk(float lo, float hi) { unsigned r; asm volatile("v_cvt_pk_bf16_f32 %0, %1, %2" : "=v"(r) : "v"(lo), "v"(hi)); return r; }
DI void partialSM(f32x16& p0, f32x16& p1, float& m_reg, float& mn, float& alpha) {
    float pmax = p0[0];
#pragma unroll
    for (int r = 1; r < 16; ++r) pmax = fmaxf(pmax, p0[r]);
#pragma unroll
    for (int r = 0; r < 16; ++r) pmax = fmaxf(pmax, p1[r]);
    { auto rr = __builtin_amdgcn_permlane32_swap(__float_as_uint(pmax), __float_as_uint(pmax), false, false);
      pmax = fmaxf(__uint_as_float(rr[0]), __uint_as_float(rr[1])); }
    if (__builtin_expect(__all(pmax - m_reg <= THR2), 1)) { mn = m_reg; alpha = 1.f; }
    else { mn = fmaxf(m_reg, pmax); alpha = ex2(m_reg - mn); m_reg = mn; }
#pragma unroll
    for (int r = 0; r < 16; ++r) { p0[r] -= mn; p1[r] -= mn; }
#pragma unroll
    for (int r = 0; r < 16; ++r) p0[r] = ex2(p0[r]);
}
DI void finishSM(f32x16& p0, f32x16& p1, float alpha, float& l_reg, bf16x8& pa0, bf16x8& pa1, bf16x8& pa2, bf16x8& pa3) {
#pragma unroll
    for (int r = 0; r < 16; ++r) p1[r] = ex2(p1[r]);
    float ps = 0;
#pragma unroll
    for (int r = 0; r < 16; ++r) ps += p0[r];
#pragma unroll
    for (int r = 0; r < 16; ++r) ps += p1[r];
    { auto rr = __builtin_amdgcn_permlane32_swap(__float_as_uint(ps), __float_as_uint(ps), false, false);
      ps = __uint_as_float(rr[0]) + __uint_as_float(rr[1]); }
    l_reg = l_reg * alpha + ps;
#define PK4(P, BASE, OUT) do { unsigned a0 = cvtpk(P[BASE + 0], P[BASE + 1]), a1 = cvtpk(P[BASE + 2], P[BASE + 3]);   \
    unsigned b0 = cvtpk(P[BASE + 4], P[BASE + 5]), b1 = cvtpk(P[BASE + 6], P[BASE + 7]);                              \
    auto r0 = __builtin_amdgcn_permlane32_swap(a0, b0, false, false); auto r1 = __builtin_amdgcn_permlane32_swap(a1, b1, false, false); \
    v4u w = {r0[0], r1[0], r0[1], r1[1]}; OUT = __builtin_bit_cast(bf16x8, w); } while (0)
    PK4(p0, 0, pa0); PK4(p0, 8, pa1); PK4(p1, 0, pa2); PK4(p1, 8, pa3);
#undef PK4
}
template <int DQK> DI void qkt(f32x16& p0, f32x16& p1, const LAS char* Ks, const bf16x8* qr, int r32, int hi) {
    constexpr int KROW = Cfg<DQK>::KROW;
    p0 = f32x16{}; p1 = f32x16{};
#pragma unroll
    for (int d0 = 0; d0 < DQK / 16; ++d0) { const int cb = (d0 * 16 + hi * 8) * 2;
        const bf16x8 b0 = *(const LAS bf16x8*)(Ks + r32 * KROW + cb);
        const bf16x8 b1 = *(const LAS bf16x8*)(Ks + (32 + r32) * KROW + cb);
        p0 = __builtin_amdgcn_mfma_f32_32x32x16_bf16(b0, qr[d0], p0, 0, 0, 0);
        p1 = __builtin_amdgcn_mfma_f32_32x32x16_bf16(b1, qr[d0], p1, 0, 0, 0); }
}
DI int v_st(int k, int c) { const int kk = (k & ~0xC) | ((k & 4) << 1) | ((k & 8) >> 1); return ((kk >> 3) * 4 + (c >> 5)) * 512 + ((kk & 7) * 32 + (c & 31)) * 2; }
DI int v_rd_base(int lane) { return ((lane & 3) << 3) | (((lane >> 2) & 3) << 6) | (((lane >> 4) & 1) << 5) | (((lane >> 5) & 1) << 8); }
constexpr int v_rd_off(int d0, int ks, int half) { return d0 * 512 + ks * 4096 + half * 2048; }
template <int OFF> DI s16x4 tr_read(int vb) { s16x4 r; asm volatile("ds_read_b64_tr_b16 %0, %1 offset:%2" : "=&v"(r) : "v"(vb), "i"(OFF) : "memory"); return r; }
template <int D0> DI void pv_one(f32x16& od, int vb, bf16x8 pa0, bf16x8 pa1, bf16x8 pa2, bf16x8 pa3) {
    const s16x4 l0 = tr_read<v_rd_off(D0, 0, 0)>(vb), h0 = tr_read<v_rd_off(D0, 0, 1)>(vb), l1 = tr_read<v_rd_off(D0, 1, 0)>(vb), h1 = tr_read<v_rd_off(D0, 1, 1)>(vb);
    const s16x4 l2 = tr_read<v_rd_off(D0, 2, 0)>(vb), h2 = tr_read<v_rd_off(D0, 2, 1)>(vb), l3 = tr_read<v_rd_off(D0, 3, 0)>(vb), h3 = tr_read<v_rd_off(D0, 3, 1)>(vb);
    asm volatile("s_waitcnt lgkmcnt(0)" ::: "memory"); SBAR();
#define PK(L, H) (bf16x8){L[0], L[1], L[2], L[3], H[0], H[1], H[2], H[3]}
    od = __builtin_amdgcn_mfma_f32_32x32x16_bf16(pa0, PK(l0, h0), od, 0, 0, 0);
    od = __builtin_amdgcn_mfma_f32_32x32x16_bf16(pa1, PK(l1, h1), od, 0, 0, 0);
    od = __builtin_amdgcn_mfma_f32_32x32x16_bf16(pa2, PK(l2, h2), od, 0, 0, 0);
    od = __builtin_amdgcn_mfma_f32_32x32x16_bf16(pa3, PK(l3, h3), od, 0, 0, 0);
#undef PK
}
DI void pv_d0(f32x16* o, int vb, bf16x8 pa0, bf16x8 pa1, bf16x8 pa2, bf16x8 pa3) {
    pv_one<0>(o[0], vb, pa0, pa1, pa2, pa3); pv_one<1>(o[1], vb, pa0, pa1, pa2, pa3); pv_one<2>(o[2], vb, pa0, pa1, pa2, pa3); pv_one<3>(o[3], vb, pa0, pa1, pa2, pa3);
}
template <int DQK, bool BIAS, int SDEPTH, int LDK, int LDV>
DI void attn_pass(LAS char* lds, const bf16* __restrict__ Qw, const bf16* __restrict__ Kh, const bf16* __restrict__ Vh,
                  int NT, int NTw, int bias_from, int bias_idx0, f32x16 (&o)[4], float& l_reg) {
    using C = Cfg<DQK>;
    constexpr int KROW = C::KROW, SHM_K = C::SHM_K, KCH = C::KCH, CPR = C::CPR;
    const int tid = ltid(), wid = __builtin_amdgcn_readfirstlane(tid >> 6), lane = tid & 63, r32 = lane & 31, hi = lane >> 5;
    LAS char* V_lds = lds + C::OFF_V; LAS char* K_lds = lds + C::OFF_K;
    LAS float* wsf = (LAS float*)(lds + C::OFF_WS) + wid * 64; LAS float* al_l = wsf + 32;
    const LAS float* btab = (const LAS float*)(lds + C::OFF_BIAS);
    float m_reg = -1e30f; l_reg = 0.f;
#pragma unroll
    for (int d = 0; d < 4; ++d) o[d] = f32x16{};
    bf16x8 qr[DQK / 16];
#pragma unroll
    for (int d0 = 0; d0 < DQK / 16; ++d0) qr[d0] = *(const bf16x8*)(Qw + d0 * 16);
#define KOFFS() unsigned kso[KCH], kdo[KCH], vso0, vso1; int vst0, vst1; { int t_ = tid; asm volatile("" : "+v"(t_)); _Pragma("unroll") for (int i_ = 0; i_ < KCH; ++i_) { const int ci_ = t_ + i_ * NTHREADS, kro_ = ci_ / CPR, kco_ = (ci_ % CPR) * 8; \
        kso[i_] = (unsigned)(kro_ * LDK + kco_) * 2u; kdo[i_] = (unsigned)(kro_ * KROW + kco_ * 2); } \
        const int sr_i = t_ >> 4, sc_i = (t_ & 15) * 8; vso0 = (unsigned)(sr_i * LDV + sc_i) * 2u; vso1 = (unsigned)((32 + sr_i) * LDV + sc_i) * 2u; vst0 = v_st(sr_i, sc_i); vst1 = v_st(32 + sr_i, sc_i); }
    const int vb0 = (int)(unsigned)(uintptr_t)V_lds + v_rd_base(lane);
    struct { bf16x8 vs0, vs1; bf16x8 ks[KCH]; } sr_[SDEPTH];
#define SLOAD(i, k0) do { KOFFS(); (void)kdo; (void)vst0; (void)vst1; const char* vb_ = (const char*)(Vh + (size_t)(k0) * LDV); const char* kb_ = (const char*)(Kh + (size_t)(k0) * LDK); \
    sr_[i].vs0 = *(const bf16x8*)(vb_ + vso0); sr_[i].vs1 = *(const bf16x8*)(vb_ + vso1); \
    _Pragma("unroll") for (int c_ = 0; c_ < KCH; ++c_) sr_[i].ks[c_] = *(const bf16x8*)(kb_ + kso[c_]); } while (0)
#define SWRITE(b, i) do { KOFFS(); (void)kso; (void)vso0; (void)vso1; *(LAS bf16x8*)(V_lds + (b) * SHM_V + vst0) = sr_[i].vs0; *(LAS bf16x8*)(V_lds + (b) * SHM_V + vst1) = sr_[i].vs1; \
    _Pragma("unroll") for (int c_ = 0; c_ < KCH; ++c_) *(LAS bf16x8*)(K_lds + (b) * SHM_K + kdo[c_]) = sr_[i].ks[c_]; } while (0)
#define SWAIT() do { if constexpr (SDEPTH == 2) { if constexpr (KCH == 1) asm volatile("s_waitcnt vmcnt(3)" ::: "memory"); else asm volatile("s_waitcnt vmcnt(5)" ::: "memory"); } \
    else asm volatile("s_waitcnt vmcnt(0)" ::: "memory"); } while (0)
#define RESC(a) do { if (__any((a) < 1.f)) { if (hi == 0) al_l[r32] = (a); asm volatile("s_waitcnt lgkmcnt(0)" ::: "memory"); \
    _Pragma("unroll") for (int d = 0; d < 4; ++d) _Pragma("unroll") for (int r = 0; r < 16; ++r) o[d][r] *= al_l[crow(r, hi)]; } } while (0)
#define ABIAS(P0, P1, t) do { if (BIAS && (t) >= bias_from) { const LAS float* bp_ = btab + (bias_idx0 + 64 * (t) + 4 * hi); \
    _Pragma("unroll") for (int r = 0; r < 16; ++r) { P0[r] += bp_[(r & 3) + 8 * (r >> 2)]; P1[r] += bp_[32 + (r & 3) + 8 * (r >> 2)]; } } } while (0)
    f32x16 pA0, pA1, pB0, pB1; float mnA, mnB, alA = 1.f, alB = 1.f; bf16x8 pa0, pa1, pa2, pa3;
    constexpr int SE = 0, SO = SDEPTH - 1;
    __syncthreads();
    SLOAD(SE, 0); asm volatile("s_waitcnt vmcnt(0)" ::: "memory"); SWRITE(0, SE); __syncthreads();
    qkt<DQK>(pA0, pA1, K_lds, qr, r32, hi); ABIAS(pA0, pA1, 0); partialSM(pA0, pA1, m_reg, mnA, alA);
    SLOAD(SO, KVBLK); if constexpr (SDEPTH == 2) { if (2 < NT) SLOAD(SE, 2 * KVBLK); }
    SWAIT(); SWRITE(1, SO); __syncthreads();
    for (int j = 1; j + 1 < NT; j += 2) {
        const bool aj = j < NTw, ajm = (j - 1) < NTw, ajp = (j + 1) < NTw;
        SBAR(); if (aj) { qkt<DQK>(pB0, pB1, K_lds + SHM_K, qr, r32, hi); ABIAS(pB0, pB1, j); }
        if (ajm) finishSM(pA0, pA1, alA, l_reg, pa0, pa1, pa2, pa3); SBAR();
        SLOAD(SO, (j + SDEPTH) * KVBLK); SBAR();
        if (ajm) pv_d0(o, vb0, pa0, pa1, pa2, pa3);
        if (aj) partialSM(pB0, pB1, m_reg, mnB, alB); else alB = 1.f;
        __syncthreads(); SWAIT(); SWRITE(0, SE);
        RESC(alB); __syncthreads();
        SBAR(); if (ajp) { qkt<DQK>(pA0, pA1, K_lds, qr, r32, hi); ABIAS(pA0, pA1, j + 1); }
        if (aj) finishSM(pB0, pB1, alB, l_reg, pa0, pa1, pa2, pa3); SBAR();
        if (SDEPTH == 1 || j + 3 < NT) SLOAD(SE, (j + 1 + SDEPTH) * KVBLK); SBAR();
        if (aj) pv_d0(o, vb0 + SHM_V, pa0, pa1, pa2, pa3);
        if (ajp) partialSM(pA0, pA1, m_reg, mnA, alA); else alA = 1.f;
        __syncthreads(); SWAIT(); SWRITE(1, SO);
        RESC(alA); __syncthreads();
    }
    { const bool aj = (NT - 1) < NTw, ajm = (NT - 2) < NTw;
      SBAR(); if (aj) { qkt<DQK>(pB0, pB1, K_lds + SHM_K, qr, r32, hi); ABIAS(pB0, pB1, NT - 1); }
      if (ajm) finishSM(pA0, pA1, alA, l_reg, pa0, pa1, pa2, pa3); SBAR();
      if (ajm) pv_d0(o, vb0, pa0, pa1, pa2, pa3);
      if (aj) partialSM(pB0, pB1, m_reg, mnB, alB); else alB = 1.f;
      __syncthreads(); RESC(alB);
      if (aj) { finishSM(pB0, pB1, alB, l_reg, pa0, pa1, pa2, pa3); SBAR(); pv_d0(o, vb0 + SHM_V, pa0, pa1, pa2, pa3); } }
#undef SLOAD
#undef KOFFS
#undef SWRITE
#undef SWAIT
#undef RESC
#undef ABIAS
}
DI void inv_l(LAS float* wsf, float l_reg, int r32, int hi, float (&rli)[16]) {
    if (hi == 0) wsf[r32] = l_reg; asm volatile("s_waitcnt lgkmcnt(0)" ::: "memory");
#pragma unroll
    for (int r = 0; r < 16; ++r) rli[r] = __builtin_amdgcn_rcpf(wsf[crow(r, hi)]);
    asm volatile("s_waitcnt lgkmcnt(0)" ::: "memory");
}
#ifndef DIFF_SDEPTH
#define DIFF_SDEPTH 1
#endif
#ifndef MLA_SDEPTH
#define MLA_SDEPTH 1
#endif
DI void mla_unit(LAS char* lds, int b, int h, int qb, const bf16* QM, const bf16* KM, const bf16* VM, bf16* MIX) {
    const int tid = ltid(), wid = __builtin_amdgcn_readfirstlane(tid >> 6), lane = tid & 63, r32 = lane & 31, hi = lane >> 5;
    const long row0 = (long)b * SEQ + qb * 256 + wid * 32;
    const bf16* Qw = QM + (row0 + r32) * UQN + h * 192 + hi * 8;
    const bf16* Kh = KM + (long)b * SEQ * UQN + h * 192; const bf16* Vh = VM + (long)b * SEQ * 768 + h * 128;
    f32x16 o[4]; float l;
    attn_pass<192, false, MLA_SDEPTH, UQN, 768>(lds, Qw, Kh, Vh, 4 * qb + 4, 4 * qb + (wid >> 1) + 1, 0, 0, o, l);
    LAS float* wsf = (LAS float*)(lds + Cfg<192>::OFF_WS) + wid * 64;
    float rli[16]; inv_l(wsf, l, r32, hi, rli);
    int r32b = r32, hib = hi; asm volatile("" : "+v"(r32b), "+v"(hib));
    bf16* Ow = MIX + row0 * D + MX_ML + h * 128 + (long)(4 * hib) * D + r32b;
#pragma unroll
    for (int r = 0; r < 16; ++r) { const int orow = (r & 3) + 8 * (r >> 2);
#pragma unroll
        for (int d0 = 0; d0 < 4; ++d0) Ow[(long)orow * D + d0 * 32] = (bf16)(pk2(o[d0][r] * rli[r], 0.f) & 0xffffu);
        asm volatile("" ::: "memory"); }
}
DI void diff_unit(LAS char* lds, int b, int h, int qb, const bf16* QN, const bf16* KN, const bf16* PROJ, float* scr, bf16* MIX, const float* bias2, float lam, float omli, const float* subln) {
    const int tid = ltid(), wid = __builtin_amdgcn_readfirstlane(tid >> 6), lane = tid & 63, r32 = lane & 31, hi = lane >> 5;
    LAS float* btab = (LAS float*)(lds + Cfg<64>::OFF_BIAS);
    __syncthreads();
    if (tid < 256) btab[tid] = bias2[h * 256 + tid];
    const int q0 = qb * 256, X = q0 + 32 * wid - 153;
    const int bias_from = X <= 0 ? 0 : ((X + 63) >> 6), bias_idx0 = 192 - (q0 + 32 * wid + r32);
    const long row0 = (long)b * SEQ + q0 + wid * 32;
    const bf16* Vh = PROJ + (long)b * SEQ * PINP + C_DV + h * 128;
    LAS float* wsf = (LAS float*)(lds + Cfg<64>::OFF_WS) + wid * 64;
    f32x16 o[4]; float l; float rli[16];
    { const bf16* Qw = QN + (row0 + r32) * 512 + h * 128 + hi * 8; const bf16* Kh = KN + (long)b * SEQ * 512 + h * 128;
      attn_pass<64, true, DIFF_SDEPTH, 512, PINP>(lds, Qw, Kh, Vh, 4 * qb + 4, 4 * qb + (wid >> 1) + 1, bias_from, bias_idx0, o, l); }
    inv_l(wsf, l, r32, hi, rli);
    int r32b = r32, hib = hi; asm volatile("" : "+v"(r32b), "+v"(hib));
    float* sw = scr + (size_t)(wid * 32) * 128 + (4 * hib) * 128 + r32b;
#pragma unroll
    for (int r = 0; r < 16; ++r) { const int orow = (r & 3) + 8 * (r >> 2);
#pragma unroll
        for (int d0 = 0; d0 < 4; ++d0) sw[orow * 128 + d0 * 32] = o[d0][r] * rli[r];
        asm volatile("" ::: "memory"); }
    { const bf16* Qw = QN + (row0 + r32) * 512 + h * 128 + 64 + hi * 8; const bf16* Kh = KN + (long)b * SEQ * 512 + h * 128 + 64;
      attn_pass<64, true, DIFF_SDEPTH, 512, PINP>(lds, Qw, Kh, Vh, 4 * qb + 4, 4 * qb + (wid >> 1) + 1, bias_from, bias_idx0, o, l); }
    inv_l(wsf, l, r32, hi, rli);
    asm volatile("" : "+v"(r32b), "+v"(hib));
    sw = scr + (size_t)(wid * 32) * 128 + (4 * hib) * 128 + r32b;
    float sg[4];
#pragma unroll
    for (int d0 = 0; d0 < 4; ++d0) sg[d0] = subln[d0 * 32 + r32b] * omli;
    bf16* Ow = MIX + row0 * D + MX_DF + h * 128 + (long)(4 * hib) * D + r32b;
#pragma unroll
    for (int r = 0; r < 16; ++r) { const int orow = (r & 3) + 8 * (r >> 2); float v[4]; float ss = 0.f;
#pragma unroll
        for (int d0 = 0; d0 < 4; ++d0) { v[d0] = sw[orow * 128 + d0 * 32] - lam * (o[d0][r] * rli[r]); ss += v[d0] * v[d0]; }
        ss += __shfl_xor(ss, 1); ss += __shfl_xor(ss, 2); ss += __shfl_xor(ss, 4); ss += __shfl_xor(ss, 8); ss += __shfl_xor(ss, 16);
        const float rn = frsqrt(ss * (1.0f / 128.0f) + EPS);
#pragma unroll
        for (int d0 = 0; d0 < 4; ++d0) Ow[(long)orow * D + d0 * 32] = (bf16)(pk2(v[d0] * rn * sg[d0], 0.f) & 0xffffu);
        asm volatile("" ::: "memory"); }
}
#undef SBAR
}

namespace hg {
constexpr int QROW = 272, PROW = 144;
DI void pre_unit(LAS char* lds, int unit, const bf16* PROJ, const float* LF, bf16* QI, bf16* Pm, bf16* KDT, bf16* VT, float* DEC) {
    const int tid = ltid(), tg = __builtin_amdgcn_readfirstlane(tid >> 6), d2 = tid & 63, lane = d2;
    const int h = unit % 6, bc = unit / 6; const long m0 = (long)bc * 64;
    LAS char* qt = lds; LAS char* kt = lds + 64 * QROW; LAS float* tot = (LAS float*)(lds + 2 * 64 * QROW);
    float c0[8], c1[8];
    { float a0 = 0.f, a1 = 0.f;
#pragma unroll
      for (int i = 0; i < 8; ++i) { const f32x2 v = *(const f32x2*)(LF + (m0 + 8 * tg + i) * HGW + h * 128 + 2 * d2); a0 += v[0]; a1 += v[1]; c0[i] = a0; c1[i] = a1; }
      tot[tg * 128 + 2 * d2] = a0; tot[tg * 128 + 2 * d2 + 1] = a1; }
    unsigned qw[8], kw[8], vw[8];
#pragma unroll
    for (int i = 0; i < 8; ++i) { const bf16* rp = PROJ + (m0 + 8 * tg + i) * PINP + h * 128 + 2 * d2;
        qw[i] = *(const unsigned*)(rp + C_HQ); kw[i] = *(const unsigned*)(rp + C_HF); vw[i] = *(const unsigned*)(rp + C_HI); }
    __syncthreads();
    float pre0 = 0.f, pre1 = 0.f, ref0 = 0.f, ref1 = 0.f, last0 = 0.f, last1 = 0.f;
#pragma unroll
    for (int g = 0; g < 8; ++g) { const float t0 = tot[g * 128 + 2 * d2], t1 = tot[g * 128 + 2 * d2 + 1];
        if (g < tg) { pre0 += t0; pre1 += t1; } if (g < 4) { ref0 += t0; ref1 += t1; } last0 += t0; last1 += t1; }
    unsigned kd0[4], kd1[4], v0[4], v1[4];
    float pkd0 = 0.f, pkd1 = 0.f;
#pragma unroll
    for (int i = 0; i < 8; ++i) { const int t = 8 * tg + i; const float cu0 = pre0 + c0[i], cu1 = pre1 + c1[i];
        const float q0 = bflo(qw[i]), q1 = bfhi(qw[i]), k0 = bflo(kw[i]), k1 = bfhi(kw[i]);
        const float e10 = fexp(fminf(cu0 - ref0, 80.f)), e11 = fexp(fminf(cu1 - ref1, 80.f));
        const float e20 = fexp(fminf(ref0 - cu0, 80.f)), e21 = fexp(fminf(ref1 - cu1, 80.f));
        *(LAS unsigned*)(qt + t * QROW + d2 * 4) = pk2(q0 * e10, q1 * e11);
        *(LAS unsigned*)(kt + t * QROW + d2 * 4) = pk2(k0 * e20, k1 * e21);
        *(unsigned*)(QI + (size_t)unit * 8192 + t * 128 + 2 * d2) = pk2(q0 * fexp(cu0), q1 * fexp(cu1));
        const float kdv0 = k0 * fexp(last0 - cu0), kdv1 = k1 * fexp(last1 - cu1);
        if (i & 1) { kd0[i >> 1] = pk2(pkd0, kdv0); kd1[i >> 1] = pk2(pkd1, kdv1); } else { pkd0 = kdv0; pkd1 = kdv1; }
    }
#pragma unroll
    for (int i = 0; i < 4; ++i) { v0[i] = (vw[2 * i] & 0xffffu) | (vw[2 * i + 1] << 16); v1[i] = (vw[2 * i] >> 16) | (vw[2 * i + 1] & 0xffff0000u); }
    { bf16* kp = KDT + (size_t)unit * 8192 + (2 * d2) * 64 + 8 * tg; *(v4u*)kp = (v4u){kd0[0], kd0[1], kd0[2], kd0[3]}; *(v4u*)(kp + 64) = (v4u){kd1[0], kd1[1], kd1[2], kd1[3]};
      bf16* vp = VT + (size_t)unit * 8192 + (2 * d2) * 64 + 8 * tg; *(v4u*)vp = (v4u){v0[0], v0[1], v0[2], v0[3]}; *(v4u*)(vp + 64) = (v4u){v1[0], v1[1], v1[2], v1[3]}; }
    if (tg == 0) { *(f32x2*)(DEC + (size_t)unit * 128 + 2 * d2) = (f32x2){fexp(last0), fexp(last1)}; }
    __syncthreads();
    { const int tb = tg >> 1, ar = lane & 15, kq = lane >> 4;
#pragma unroll
      for (int sbi = 0; sbi < 2; ++sbi) { const int sb = 2 * (tg & 1) + sbi; f32x4 acc = {0.f, 0.f, 0.f, 0.f};
          if (sb <= tb) {
#pragma unroll
              for (int ks = 0; ks < 4; ++ks) { const bf16x8 a = *(const LAS bf16x8*)(qt + (16 * tb + ar) * QROW + (32 * ks + 8 * kq) * 2);
                  const bf16x8 bb = *(const LAS bf16x8*)(kt + (16 * sb + ar) * QROW + (32 * ks + 8 * kq) * 2); acc = mfma16(a, bb, acc); } }
#pragma unroll
          for (int i = 0; i < 4; ++i) { const int t = 16 * tb + 4 * kq + i, s = 16 * sb + ar; const float v = (s <= t) ? acc[i] : 0.f;
              Pm[(size_t)unit * 4096 + t * 64 + s] = (bf16)(pk2(v, 0.f) & 0xffffu); } } }
    __syncthreads();
}
constexpr int L_QI = 0, L_P = 64 * QROW, L_KD = L_P + 64 * PROW, L_VT = L_KD + 128 * PROW, L_ST = L_VT + 128 * PROW, L_DEC = L_ST + 128 * QROW, L_END = L_DEC + 512;
constexpr int L_O = 0, OROW = 528;
static_assert(64 * OROW <= L_VT && L_END <= RING_BYTES, "hgrn chain LDS map");
DI void chain(LAS char* lds, int b, int h, const bf16* QI, const bf16* Pm, const bf16* KDT, const bf16* VT, const float* DEC, const bf16* PROJ, bf16* MIX, const float* ogain) {
    const int tid = ltid(), w = __builtin_amdgcn_readfirstlane(tid >> 6), lane = tid & 63, ar = lane & 15, kq = lane >> 4;
    __syncthreads();
    for (int i = tid; i < 128 * QROW / 4; i += NTHREADS) ((LAS unsigned*)(lds + L_ST))[i] = 0u;
    f32x4 S[8];
#pragma unroll
    for (int db = 0; db < 8; ++db) S[db] = (f32x4){0.f, 0.f, 0.f, 0.f};
    v4u rq[2], rp, rk[2], rv[2]; f32x4 rdec = {0.f, 0.f, 0.f, 0.f};
#define HLOAD(c) do { const size_t un_ = (size_t)((b * 64 + (c)) * 6 + h); \
    _Pragma("unroll") for (int i_ = 0; i_ < 2; ++i_) { const int ci_ = tid + i_ * NTHREADS; rq[i_] = *(const v4u*)(QI + un_ * 8192 + ci_ * 8); rk[i_] = *(const v4u*)(KDT + un_ * 8192 + ci_ * 8); rv[i_] = *(const v4u*)(VT + un_ * 8192 + ci_ * 8); } \
    rp = *(const v4u*)(Pm + un_ * 4096 + tid * 8); if (tid < 32) rdec = *(const f32x4*)(DEC + un_ * 128 + tid * 4); } while (0)
    HLOAD(0);
    const float og = 0.f; (void)og;
    for (int c = 0; c < 64; ++c) {
#pragma unroll
        for (int i = 0; i < 2; ++i) { const int ci = tid + i * NTHREADS;
            *(LAS v4u*)(lds + L_QI + (ci >> 4) * QROW + (ci & 15) * 16) = rq[i];
            *(LAS v4u*)(lds + L_KD + (ci >> 3) * PROW + (ci & 7) * 16) = rk[i];
            *(LAS v4u*)(lds + L_VT + (ci >> 3) * PROW + (ci & 7) * 16) = rv[i]; }
        *(LAS v4u*)(lds + L_P + (tid >> 3) * PROW + (tid & 7) * 16) = rp;
        if (tid < 32) *(LAS f32x4*)(lds + L_DEC + tid * 16) = rdec;
        __syncthreads();
        if (c + 1 < 64) HLOAD(c + 1);
        f32x4 ao[4];
#pragma unroll
        for (int tb = 0; tb < 4; ++tb) ao[tb] = (f32x4){0.f, 0.f, 0.f, 0.f};
        bf16x8 bv[2];
#pragma unroll
        for (int ks = 0; ks < 4; ++ks) { const bf16x8 bs = *(const LAS bf16x8*)(lds + L_ST + (16 * w + ar) * QROW + (32 * ks + 8 * kq) * 2);
#pragma unroll
            for (int tb = 0; tb < 4; ++tb) { const bf16x8 a = *(const LAS bf16x8*)(lds + L_QI + (16 * tb + ar) * QROW + (32 * ks + 8 * kq) * 2); ao[tb] = mfma16(a, bs, ao[tb]); } }
#pragma unroll
        for (int ks = 0; ks < 2; ++ks) { bv[ks] = *(const LAS bf16x8*)(lds + L_VT + (16 * w + ar) * PROW + (32 * ks + 8 * kq) * 2);
#pragma unroll
            for (int tb = 0; tb < 4; ++tb) { const bf16x8 a = *(const LAS bf16x8*)(lds + L_P + (16 * tb + ar) * PROW + (32 * ks + 8 * kq) * 2); ao[tb] = mfma16(a, bv[ks], ao[tb]); } }
#pragma unroll
        for (int db = 0; db < 8; ++db) { const f32x4 dc = *(const LAS f32x4*)(lds + L_DEC + (16 * db + 4 * kq) * 4); S[db] = S[db] * dc;
#pragma unroll
            for (int ks = 0; ks < 2; ++ks) { const bf16x8 a = *(const LAS bf16x8*)(lds + L_KD + (16 * db + ar) * PROW + (32 * ks + 8 * kq) * 2); S[db] = mfma16(a, bv[ks], S[db]); } }
        __syncthreads();
#pragma unroll
        for (int db = 0; db < 8; ++db) { typedef unsigned u32x2 __attribute__((ext_vector_type(2)));
            *(LAS u32x2*)(lds + L_ST + (16 * w + ar) * QROW + (16 * db + 4 * kq) * 2) = (u32x2){pk2(S[db][0], S[db][1]), pk2(S[db][2], S[db][3])}; }
#pragma unroll
        for (int tb = 0; tb < 4; ++tb)
#pragma unroll
            for (int i = 0; i < 4; ++i) *(LAS float*)(lds + L_O + (16 * tb + 4 * kq + i) * OROW + (16 * w + ar) * 4) = ao[tb][i];
        __syncthreads();
        { const int t = tid >> 3, sg = tid & 7; const long row = (long)b * SEQ + c * 64 + t;
          f32x4 ov[4]; float ss = 0.f;
#pragma unroll
          for (int q = 0; q < 4; ++q) { ov[q] = *(const LAS f32x4*)(lds + L_O + t * OROW + (16 * sg + 4 * q) * 4); ss += (ov[q][0] * ov[q][0] + ov[q][1] * ov[q][1]) + (ov[q][2] * ov[q][2] + ov[q][3] * ov[q][3]); }
          ss += __shfl_xor(ss, 1); ss += __shfl_xor(ss, 2); ss += __shfl_xor(ss, 4);
          const float rn = frsqrt(ss * (1.0f / 128.0f) + EPS);
          const v4u g0 = *(const v4u*)(PROJ + row * PINP + C_HG + h * 128 + 16 * sg), g1 = *(const v4u*)(PROJ + row * PINP + C_HG + h * 128 + 16 * sg + 8);
          const unsigned gw[8] = {g0.x, g0.y, g0.z, g0.w, g1.x, g1.y, g1.z, g1.w};
          unsigned ow[8];
#pragma unroll
          for (int q = 0; q < 4; ++q) { const f32x4 gn = *(const f32x4*)(ogain + 16 * sg + 4 * q);
              ow[2 * q] = pk2(ov[q][0] * rn * gn[0] * bflo(gw[2 * q]), ov[q][1] * rn * gn[1] * bfhi(gw[2 * q]));
              ow[2 * q + 1] = pk2(ov[q][2] * rn * gn[2] * bflo(gw[2 * q + 1]), ov[q][3] * rn * gn[3] * bfhi(gw[2 * q + 1])); }
          bf16* op = MIX + row * D + MX_HG + h * 128 + 16 * sg;
          *(v4u*)op = (v4u){ow[0], ow[1], ow[2], ow[3]}; *(v4u*)(op + 8) = (v4u){ow[4], ow[5], ow[6], ow[7]}; }
        __syncthreads();
    }
#undef HLOAD
}
}

DI void mla_prep_unit(int u, const bf16* PROJ, const bf16* WUQ, const bf16* WUKV, const f32x2* rope, const float* qg, const float* kg, bf16* QM, bf16* KM, bf16* VM) {
    const int tid = ltid(), wid = __builtin_amdgcn_readfirstlane(tid >> 6), lane = tid & 63, ar = lane & 15, kq = lane >> 4;
    const int rt = u / 12, kind = u % 12; const long m0 = (long)rt * 128 + 16 * wid;
    if (kind < 6) {
        const int h = kind; f32x4 acc[12];
#pragma unroll
        for (int nb = 0; nb < 12; ++nb) acc[nb] = (f32x4){0.f, 0.f, 0.f, 0.f};
        float ssq = 0.f; const bf16* ap = PROJ + (m0 + ar) * PINP + C_CQ + 8 * kq; const bf16* bp = WUQ + (size_t)(h * 192 + ar) * 512 + 8 * kq;
#pragma unroll 2
        for (int ks = 0; ks < 16; ++ks) { const v4u aw = *(const v4u*)(ap + 32 * ks); const bf16x8 a = __builtin_bit_cast(bf16x8, aw);
            ssq += (bflo(aw.x) * bflo(aw.x) + bfhi(aw.x) * bfhi(aw.x)) + (bflo(aw.y) * bflo(aw.y) + bfhi(aw.y) * bfhi(aw.y)) + (bflo(aw.z) * bflo(aw.z) + bfhi(aw.z) * bfhi(aw.z)) + (bflo(aw.w) * bflo(aw.w) + bfhi(aw.w) * bfhi(aw.w));
#pragma unroll
            for (int nb = 0; nb < 12; ++nb) { const bf16x8 bb = *(const bf16x8*)(bp + (size_t)nb * 16 * 512 + 32 * ks); acc[nb] = mfma16(a, bb, acc[nb]); } }
        ssq += __shfl_xor(ssq, 16); ssq += __shfl_xor(ssq, 32);
        float gq[12];
#pragma unroll
        for (int nb = 0; nb < 12; ++nb) gq[nb] = qg[16 * nb + ar];
#pragma unroll
        for (int i = 0; i < 4; ++i) { const long row = m0 + 4 * kq + i; const float rs = frsqrt(__shfl(ssq, 4 * kq + i) * (1.0f / 512.0f) + EPS);
            float v[12]; float ss = 0.f;
#pragma unroll
            for (int nb = 0; nb < 12; ++nb) { v[nb] = acc[nb][i] * rs; ss += v[nb] * v[nb]; }
            ss += __shfl_xor(ss, 1); ss += __shfl_xor(ss, 2); ss += __shfl_xor(ss, 4); ss += __shfl_xor(ss, 8);
            const float rn = frsqrt(ss * (1.0f / 192.0f) + EPS);
#pragma unroll
            for (int nb = 0; nb < 12; ++nb) v[nb] = v[nb] * rn * gq[nb];
            const int pos = (int)(row & (SEQ - 1));
#pragma unroll
            for (int jb = 0; jb < 2; ++jb) { const f32x2 cs = rope[pos * 32 + 16 * jb + ar]; const float x1 = v[8 + jb], x2 = v[10 + jb]; v[8 + jb] = x1 * cs[0] - x2 * cs[1]; v[10 + jb] = x2 * cs[0] + x1 * cs[1]; }
            bf16* op = QM + row * UQN + h * 192 + ar;
#pragma unroll
            for (int nb = 0; nb < 12; ++nb) op[16 * nb] = (bf16)(pk2(v[nb] * SC_MQ, 0.f) & 0xffffu); }
    } else {
        const int h = kind - 6; f32x4 acc[16];
#pragma unroll
        for (int nb = 0; nb < 16; ++nb) acc[nb] = (f32x4){0.f, 0.f, 0.f, 0.f};
        float ssq = 0.f; const bf16* ap = PROJ + (m0 + ar) * PINP + C_CKV + 8 * kq; const bf16* bp = WUKV + (size_t)(h * 256 + ar) * 256 + 8 * kq;
#pragma unroll 2
        for (int ks = 0; ks < 8; ++ks) { const v4u aw = *(const v4u*)(ap + 32 * ks); const bf16x8 a = __builtin_bit_cast(bf16x8, aw);
            ssq += (bflo(aw.x) * bflo(aw.x) + bfhi(aw.x) * bfhi(aw.x)) + (bflo(aw.y) * bflo(aw.y) + bfhi(aw.y) * bfhi(aw.y)) + (bflo(aw.z) * bflo(aw.z) + bfhi(aw.z) * bfhi(aw.z)) + (bflo(aw.w) * bflo(aw.w) + bfhi(aw.w) * bfhi(aw.w));
#pragma unroll
            for (int nb = 0; nb < 16; ++nb) { const bf16x8 bb = *(const bf16x8*)(bp + (size_t)nb * 16 * 256 + 32 * ks); acc[nb] = mfma16(a, bb, acc[nb]); } }
        ssq += __shfl_xor(ssq, 16); ssq += __shfl_xor(ssq, 32);
        float gk[12];
#pragma unroll
        for (int nb = 0; nb < 12; ++nb) gk[nb] = kg[16 * nb + ar];
#pragma unroll
        for (int i = 0; i < 4; ++i) { const long row = m0 + 4 * kq + i; const float rs = frsqrt(__shfl(ssq, 4 * kq + i) * (1.0f / 256.0f) + EPS);
            float v[12]; float ss = 0.f;
#pragma unroll
            for (int nb = 0; nb < 8; ++nb) { v[nb] = acc[nb][i] * rs; ss += v[nb] * v[nb]; }
#pragma unroll
            for (int jb = 0; jb < 4; ++jb) { v[8 + jb] = bf2f(PROJ[row * PINP + C_KR + 16 * jb + ar]); ss += v[8 + jb] * v[8 + jb]; }
            ss += __shfl_xor(ss, 1); ss += __shfl_xor(ss, 2); ss += __shfl_xor(ss, 4); ss += __shfl_xor(ss, 8);
            const float rn = frsqrt(ss * (1.0f / 192.0f) + EPS);
#pragma unroll
            for (int nb = 0; nb < 12; ++nb) v[nb] = v[nb] * rn * gk[nb];
            const int pos = (int)(row & (SEQ - 1));
#pragma unroll
            for (int jb = 0; jb < 2; ++jb) { const f32x2 cs = rope[pos * 32 + 16 * jb + ar]; const float x1 = v[8 + jb], x2 = v[10 + jb]; v[8 + jb] = x1 * cs[0] - x2 * cs[1]; v[10 + jb] = x2 * cs[0] + x1 * cs[1]; }
            bf16* kp = KM + row * UQN + h * 192 + ar;
#pragma unroll
            for (int nb = 0; nb < 12; ++nb) kp[16 * nb] = (bf16)(pk2(v[nb], 0.f) & 0xffffu);
            bf16* vp = VM + row * 768 + h * 128 + ar;
#pragma unroll
            for (int nb = 0; nb < 8; ++nb) vp[16 * nb] = (bf16)(pk2(acc[8 + nb][i] * rs, 0.f) & 0xffffu); }
    }
}
DI void diff_norm_unit(int du, const bf16* PROJ, const float* qg, const float* kg, bf16* QN, bf16* KN) {
    const int tid = ltid(), wid = __builtin_amdgcn_readfirstlane(tid >> 6), lane = tid & 63;
    float gqv[8], gkv[8];
#pragma unroll
    for (int j = 0; j < 8; ++j) { gqv[j] = qg[((8 * lane) & 63) + j] * SC_DQ; gkv[j] = kg[((8 * lane) & 63) + j]; }
#pragma unroll 2
    for (int i = 0; i < 8; ++i) { const long row = (long)du * 64 + wid * 8 + i;
#pragma unroll
        for (int which = 0; which < 2; ++which) { const v4u w = *(const v4u*)(PROJ + row * PINP + (which ? C_DK : C_DQ) + 8 * lane);
            float v[8] = {bflo(w.x), bfhi(w.x), bflo(w.y), bfhi(w.y), bflo(w.z), bfhi(w.z), bflo(w.w), bfhi(w.w)}; float ss = 0.f;
#pragma unroll
            for (int j = 0; j < 8; ++j) ss += v[j] * v[j];
            ss += __shfl_xor(ss, 1); ss += __shfl_xor(ss, 2); ss += __shfl_xor(ss, 4);
            const float rn = frsqrt(ss * (1.0f / 64.0f) + EPS);
#pragma unroll
            for (int j = 0; j < 8; ++j) v[j] = v[j] * rn * (which ? gkv[j] : gqv[j]);
            *(v4u*)((which ? KN : QN) + row * 512 + 8 * lane) = (v4u){pk2(v[0], v[1]), pk2(v[2], v[3]), pk2(v[4], v[5]), pk2(v[6], v[7])}; } }
}

DI void tr_item(const float* W, int K, int N, const float* gain, bf16* WT, int dst_row0, int k0, int n0, LAS float* scr, int lane) {
#pragma unroll 8
    for (int i = 0; i < 32; ++i) { const int kk = 2 * i + (lane >> 5); float v = W[(size_t)(k0 + kk) * N + n0 + (lane & 31)]; if (gain) v *= gain[k0 + kk]; scr[kk * 33 + (lane & 31)] = v; }
    LDS_WAIT(); asm volatile("" ::: "memory");
    const int c = lane & 7;
#pragma unroll
    for (int j = 0; j < 4; ++j) { const int n = (lane >> 3) + 8 * j; const LAS float* s = scr + (8 * c) * 33 + n;
        v4u o; o.x = pk2(s[0 * 33], s[1 * 33]); o.y = pk2(s[2 * 33], s[3 * 33]); o.z = pk2(s[4 * 33], s[5 * 33]); o.w = pk2(s[6 * 33], s[7 * 33]);
        *(v4u*)(WT + (size_t)(dst_row0 + n) * K + k0 + 8 * c) = o; }
    LDS_WAIT(); asm volatile("" ::: "memory");
}
DI int t5_bucket(int rel) {
    const int n = rel < 0 ? -rel : rel; int v;
    if (n < 8) v = n; else if (n < 12) v = 8; else if (n < 16) v = 9; else if (n < 23) v = 10; else if (n < 32) v = 11; else if (n < 46) v = 12; else if (n < 64) v = 13; else if (n < 91) v = 14; else v = 15;
    return (rel > 0 ? 16 : 0) + v;
}

struct Args {
    const float* in[28];
    float* out; unsigned char* ws;
    int ph_lo, ph_hi;
};
enum { I_X = 0, I_FA_NORM, I_FA_G, I_FA_U, I_FA_D, I_MIX_NORM, I_WIN, I_WOUT, I_LB, I_HG_ON, I_DQN, I_DKN, I_LQ1, I_LK1, I_LQ2, I_LK2, I_SUBLN, I_RELB, I_QLN, I_WUQ, I_KVLN, I_WUKV, I_MQN, I_MKN, I_FB_NORM, I_FB_G, I_FB_U, I_FB_D };

constexpr int TR_G = (D / 64) * (F / 32), TR_DN = (F / 64) * (D / 32), TR_IN = (D / 64) * (PIN / 32), TR_OUT = (D / 64) * (D / 32), TR_UQ = (512 / 64) * (UQN / 32), TR_UKV = (256 / 64) * (UKVN / 32);
constexpr int TR_LAYER = 6 * TR_G + TR_IN + TR_OUT + TR_UQ + TR_UKV;
static_assert(TR_DN == TR_G, "item counts");

DI void prologue(const Args& A, LAS unsigned char* lds, int G) {
    const int tid = ltid(), lane = tid & 63, wave = __builtin_amdgcn_readfirstlane(tid >> 6);
    unsigned char* ws = A.ws;
    LAS float* scr = (LAS float*)(lds + wave * 16384);
    const int gw = blockIdx.x * NWAVES + wave, NGW = G * NWAVES;
    for (int it = gw; it < NL * TR_LAYER; it += NGW) {
        const int l = it / TR_LAYER; int r = it % TR_LAYER; unsigned char* wl = ws + WS_W + (size_t)l * W_LAYER;
        if (r < 6 * TR_G) { const int which = r / TR_G; r -= which * TR_G;
            const bool isb = which >= 3; const int kind = which % 3;
            if (kind < 2) { const int nblk = F / 32, kb = r / nblk, nb = r % nblk, n0 = 32 * nb;
                const float* W = A.in[(isb ? I_FB_G : I_FA_G) + kind] + (size_t)l * D * F; const float* gn = A.in[isb ? I_FB_NORM : I_FA_NORM] + (size_t)l * D;
                tr_item(W, D, F, gn, (bf16*)(wl + (isb ? WO_GUB : WO_GUA)), (n0 >> 7) * 256 + (n0 & 127) + kind * 128, 64 * kb, n0, scr, lane); }
            else { const int nblk = D / 32, kb = r / nblk, nb = r % nblk;
                const float* W = A.in[isb ? I_FB_D : I_FA_D] + (size_t)l * F * D;
                tr_item(W, F, D, nullptr, (bf16*)(wl + (isb ? WO_DB : WO_DA)), 32 * nb, 64 * kb, 32 * nb, scr, lane); }
            continue; }
        r -= 6 * TR_G;
        if (r < TR_IN) { const int nblk = PIN / 32, kb = r / nblk, nb = r % nblk;
            tr_item(A.in[I_WIN] + (size_t)l * D * PIN, D, PIN, A.in[I_MIX_NORM] + (size_t)l * D, (bf16*)(wl + WO_IN), 32 * nb, 64 * kb, 32 * nb, scr, lane); continue; }
        r -= TR_IN;
        if (r < TR_OUT) { const int nblk = D / 32, kb = r / nblk, nb = r % nblk;
            tr_item(A.in[I_WOUT] + (size_t)l * D * D, D, D, nullptr, (bf16*)(wl + WO_OUT), 32 * nb, 64 * kb, 32 * nb, scr, lane); continue; }
        r -= TR_OUT;
        if (r < TR_UQ) { const int nblk = UQN / 32, kb = r / nblk, nb = r % nblk;
            tr_item(A.in[I_WUQ] + (size_t)l * 512 * UQN, 512, UQN, A.in[I_QLN] + (size_t)l * 512, (bf16*)(wl + WO_UQ), 32 * nb, 64 * kb, 32 * nb, scr, lane); continue; }
        r -= TR_UQ;
        { const int nblk = UKVN / 32, kb = r / nblk, nb = r % nblk;
            tr_item(A.in[I_WUKV] + (size_t)l * 256 * UKVN, 256, UKVN, A.in[I_KVLN] + (size_t)l * 256, (bf16*)(wl + WO_UKV), 32 * nb, 64 * kb, 32 * nb, scr, lane); }
    }
    { const int gt = blockIdx.x * NTHREADS + tid, NGT = G * NTHREADS; constexpr int PER = (PINP - PIN) * D / 8;
      for (int i = gt; i < NL * PER; i += NGT) { const int l = i / PER, r = i % PER; *(v4u*)(ws + WS_W + (size_t)l * W_LAYER + WO_IN + (size_t)PIN * D * 2 + (size_t)r * 16) = (v4u){0u, 0u, 0u, 0u}; }
      float* LB = (float*)(ws + WS_CONST + CO_LB); float* LAM = (float*)(ws + WS_CONST + CO_LAM); float* BIAS = (float*)(ws + WS_CONST + CO_BIAS); f32x2* ROPE = (f32x2*)(ws + WS_CONST + CO_ROPE);
      for (int c = gt; c < HGW; c += NGT) { const float* lg = A.in[I_LB]; const float a0 = lg[c], a1 = lg[HGW + c], a2 = lg[2 * HGW + c], a3 = lg[3 * HGW + c];
          const float mx = fmaxf(fmaxf(a0, a1), fmaxf(a2, a3)); const float e0 = expf(a0 - mx), e1 = expf(a1 - mx), e2 = expf(a2 - mx), e3 = expf(a3 - mx); const float inv = 1.0f / (e0 + e1 + e2 + e3);
          const float p0 = e0 * inv, p1 = e1 * inv, p2 = e2 * inv, p3 = e3 * inv; const float c0 = p0, c1 = c0 + p1, c2 = c1 + p2, c3 = c2 + p3;
          LB[c] = c0 - c0; LB[HGW + c] = c1 - c0; LB[2 * HGW + c] = c2 - c0; LB[3 * HGW + c] = c3 - c0; }
      if (gt < NL) { const int l = gt; float s1 = 0.f, s2 = 0.f;
          for (int j = 0; j < 64; ++j) { s1 += A.in[I_LQ1][l * 64 + j] * A.in[I_LK1][l * 64 + j]; s2 += A.in[I_LQ2][l * 64 + j] * A.in[I_LK2][l * 64 + j]; }
          LAM[l] = expf(s1) - expf(s2) + (0.8f - 0.6f * expf(-0.3f * (float)l)); }
      for (int i = gt; i < 4 * 256; i += NGT) { const int h = i >> 8, rel = (i & 255) - 192; const float* rb = A.in[I_RELB];
          BIAS[i] = (rb[t5_bucket(rel) * 4 + h] - rb[15 * 4 + h]) * LOG2E; }
      for (int i = gt; i < SEQ * 32; i += NGT) { const int pos = i >> 5, j = i & 31; const float freq = exp2f(-(float)j * (13.287712379549449f / 32.0f)); const float ang = (float)pos * freq;
          double rev = (double)ang * 0.15915494309189535; rev -= floor(rev); const float rf = (float)rev;
          ROPE[i] = (f32x2){__builtin_amdgcn_cosf(rf), __builtin_amdgcn_sinf(rf)}; }
    }
    { bf16* XB = (bf16*)(ws + WS_XB); float* ST = (float*)(ws + WS_STATS);
      for (int m = gw; m < M; m += NGW) { const f32x4* xr = (const f32x4*)(A.in[I_X] + (size_t)m * D) + lane; f32x4* orow = (f32x4*)(A.out + (size_t)m * D) + lane; float s = 0.f;
          typedef unsigned u32x2 __attribute__((ext_vector_type(2)));
#pragma unroll
          for (int j = 0; j < 8; ++j) { const f32x4 v = xr[64 * j]; orow[64 * j] = v; s += (v[0] * v[0] + v[1] * v[1]) + (v[2] * v[2] + v[3] * v[3]);
              *((u32x2*)(XB + (size_t)m * D) + lane + 64 * j) = (u32x2){pk2(v[0], v[1]), pk2(v[2], v[3])}; }
          s = wave_sum(s); if (lane < 32) ST[(size_t)m * 32 + lane] = lane == 0 ? s : 0.f; } }
}

__global__ void __launch_bounds__(NTHREADS, 2) fwd_kernel(Args args) {
    extern __shared__ __attribute__((aligned(16))) unsigned char lds_raw[];
    LAS unsigned char* lds = (LAS unsigned char*)lds_raw;
    volatile LAS unsigned* MISC = (volatile LAS unsigned*)(lds + MISC_OFF);
    const int tid = threadIdx.x, G = gridDim.x;
    gu32* ctl = (gu32*)(args.ws + WS_CTL);
    for (int u = tid; u < (LDS_BYTES - LDSCTL_OFF) / 4; u += NTHREADS) ((LAS unsigned*)(lds + LDSCTL_OFF))[u] = 0u;
    __syncthreads();
    XcdBarrier bar = xcd_barrier_post((unsigned*)(ctl + CW_BAR), MISC + 8);
    const int lo = args.ph_lo, hi = args.ph_hi;
    int ph = 0;
#define IN(k) (lo <= (k) && (k) < hi)
#define SEAM(k) do { if (IN(k) && IN((k) + 1)) xcd_barrier(bar); } while (0)

#define WS_PTRS() const unsigned long long ws_u_ = (unsigned long long)args.ws; unsigned char* ws = (unsigned char*)(GAS unsigned char*)ws_u_; \
    bf16* XB = (bf16*)(ws + WS_XB); float* STATS = (float*)(ws + WS_STATS); bf16* HB = (bf16*)(ws + WS_A); bf16* PROJ = (bf16*)(ws + WS_A); float* LF = (float*)(ws + WS_LF); \
    bf16* QI = (bf16*)(ws + WS_QI); bf16* PM = (bf16*)(ws + WS_P); bf16* KDT = (bf16*)(ws + WS_KDT); bf16* VT = (bf16*)(ws + WS_VT); float* DEC = (float*)(ws + WS_DEC); \
    bf16* QM = (bf16*)(ws + WS_QM); bf16* KM = (bf16*)(ws + WS_KM); bf16* VM = (bf16*)(ws + WS_VM); bf16* QN = (bf16*)(ws + WS_QN); bf16* KN = (bf16*)(ws + WS_KN); \
    float* SCR = (float*)(ws + WS_SCR); bf16* MIX = (bf16*)(ws + WS_MIX); \
    const float* LB = (const float*)(ws + WS_CONST + CO_LB); const float* LAM = (const float*)(ws + WS_CONST + CO_LAM); const float* BIAS = (const float*)(ws + WS_CONST + CO_BIAS); const f32x2* ROPE = (const f32x2*)(ws + WS_CONST + CO_ROPE); \
    unsigned char* wl = ws + WS_W + (size_t)l * W_LAYER; \
    (void)XB; (void)STATS; (void)HB; (void)PROJ; (void)LF; (void)QI; (void)PM; (void)KDT; (void)VT; (void)DEC; (void)QM; (void)KM; (void)VM; (void)QN; (void)KN; (void)SCR; (void)MIX; (void)LB; (void)LAM; (void)BIAS; (void)ROPE; (void)wl

#ifndef NO_PRO
    if (IN(ph)) prologue(args, lds, G);
#endif
    SEAM(ph); ++ph;

    for (int s = 0; s < 3 * NL; ++s) {
        const int l = s / 3, kind = s % 3;
        if (kind != 1) {
#ifndef NO_FFN1
            if (IN(ph)) { WS_PTRS(); const bf16* Wgu = (const bf16*)(wl + (kind == 0 ? WO_GUA : WO_GUB)); pg8::Gemm g{XB, Wgu, M, NGU, D}; pg8::StaticOrder S; S.init(M, NGU, G, (int)blockIdx.x); EpiSwiGLU E{HB, STATS};
                pg8::gemm_phase<EpiSwiGLU, pg8::StaticOrder, true, true>(lds, g, S, E); }
#endif
            SEAM(ph); ++ph;
#ifndef NO_FFN2
            if (IN(ph)) { WS_PTRS(); const bf16* Wdn = (const bf16*)(wl + (kind == 0 ? WO_DA : WO_DB)); pg8::Gemm g{HB, Wdn, M, D, F}; pg8::StaticOrder S; S.init(M, D, G, (int)blockIdx.x); EpiResid E{args.out, XB, STATS, 0.5f};
                pg8::gemm_phase<EpiResid, pg8::StaticOrder, true, true>(lds, g, S, E); }
#endif
            SEAM(ph); ++ph;
        } else {
#ifndef NO_WIN
            if (IN(ph)) { WS_PTRS(); pg8::Gemm g{XB, (const bf16*)(wl + WO_IN), M, PINP, D}; pg8::StaticOrder S; S.init(M, PINP, G, (int)blockIdx.x); EpiProj E{PROJ, LF, STATS, LB + l * HGW};
                pg8::gemm_phase<EpiProj, pg8::StaticOrder, true, true>(lds, g, S, E); }
#endif
            SEAM(ph); ++ph;
            if (IN(ph)) { WS_PTRS();
#ifndef NO_HPRE
                for (int u = blockIdx.x; u < 1536; u += G) hg::pre_unit((LAS char*)lds, u, PROJ, LF, QI, PM, KDT, VT, DEC);
#endif
#ifndef NO_MPREP
                for (int u = blockIdx.x; u < 1536; u += G) mla_prep_unit(u, PROJ, (const bf16*)(wl + WO_UQ), (const bf16*)(wl + WO_UKV), ROPE, args.in[I_MQN] + l * 192, args.in[I_MKN] + l * 192, QM, KM, VM);
#endif
#ifndef NO_DNORM
                for (int u = blockIdx.x; u < 256; u += G) diff_norm_unit(u, PROJ, args.in[I_DQN] + l * 64, args.in[I_DKN] + l * 64, QN, KN);
#endif
            }
            SEAM(ph); ++ph;
            if (IN(ph)) { WS_PTRS();
#ifndef NO_CHAIN
                if (blockIdx.x < 24) hg::chain((LAS char*)lds, blockIdx.x / 6, blockIdx.x % 6, QI, PM, KDT, VT, DEC, PROJ, MIX, args.in[I_HG_ON] + l * 128);
#endif
                const float lam = LAM[l], omli = 1.0f - (0.8f - 0.6f * expf(-0.3f * (float)l));
                for (;;) {
                    __syncthreads();
                    if (tid == 0) MISC[0] = __hip_atomic_fetch_add((unsigned*)(ctl + CW_Q + 64 * l), 1u, __ATOMIC_RELAXED, __HIP_MEMORY_SCOPE_AGENT);
                    __syncthreads();
                    const int u = (int)MISC[0];
                    if (u >= 640) break;
                    const int qb = 15 - u / 40, r = u % 40;
#ifndef NO_DIFF
                    if (r < 16) att::diff_unit((LAS char*)lds, r >> 2, r & 3, qb, QN, KN, PROJ, SCR + (size_t)blockIdx.x * 256 * 128, MIX, BIAS, lam, omli, args.in[I_SUBLN] + l * 128);
#endif
#ifndef NO_MLA
                    if (r >= 16) att::mla_unit((LAS char*)lds, (r - 16) / 6, (r - 16) % 6, qb, QM, KM, VM, MIX);
#endif
                }
            }
            SEAM(ph); ++ph;
#ifndef NO_WOUT
            if (IN(ph)) { WS_PTRS(); pg8::Gemm g{MIX, (const bf16*)(wl + WO_OUT), M, D, D}; pg8::StaticOrder S; S.init(M, D, G, (int)blockIdx.x); EpiResid E{args.out, XB, STATS, 1.0f};
                pg8::gemm_phase<EpiResid, pg8::StaticOrder, true, true>(lds, g, S, E); }
#endif
            SEAM(ph); ++ph;
        }
    }
#undef IN
#undef SEAM
}
constexpr int N_PHASES = 1 + NL * (2 + 4 + 2);

#ifndef MK_MULTI
#define MK_MULTI 0
#endif
extern "C" void kernel_launch(void* const* d_in, const int* in_sizes, int n_in, void* d_out, int out_size, void* d_ws, size_t ws_size, hipStream_t stream) {
    static int grid = 0;
    if (grid == 0) {
        if (n_in != 28 || in_sizes[0] != M * D || out_size != M * D || ws_size < WS_END) { fprintf(stderr, "kernel_launch: shape mismatch: n_in %d in0 %d out %d ws %zu (need %zu)\n", n_in, n_in > 0 ? in_sizes[0] : -1, out_size, ws_size, (size_t)WS_END); grid = -1; return; }
        int dev = 0, cus = 0, per_cu = 0;
        if (hipGetDevice(&dev) != hipSuccess || hipDeviceGetAttribute(&cus, hipDeviceAttributeMultiprocessorCount, dev) != hipSuccess) { fprintf(stderr, "kernel_launch: device query failed\n"); grid = -1; return; }
        if (hipFuncSetAttribute((const void*)fwd_kernel, hipFuncAttributeMaxDynamicSharedMemorySize, LDS_BYTES) != hipSuccess) { fprintf(stderr, "kernel_launch: hipFuncSetAttribute failed\n"); grid = -1; return; }
        if (hipOccupancyMaxActiveBlocksPerMultiprocessor(&per_cu, (const void*)fwd_kernel, NTHREADS, LDS_BYTES) != hipSuccess || per_cu < 1) fprintf(stderr, "kernel_launch: note: occupancy query reports %d workgroups per CU\n", per_cu);
        (void)hipGetLastError();
        grid = cus;
    }
    if (grid < 0) return;
    if (hipMemsetAsync((char*)d_ws + WS_CTL, 0, CTL_ZERO_BYTES, stream) != hipSuccess) { fprintf(stderr, "kernel_launch: memset failed\n"); return; }
    Args a{};
    for (int i = 0; i < 28; ++i) a.in[i] = (const float*)d_in[i];
    a.out = (float*)d_out; a.ws = (unsigned char*)d_ws;
#if MK_MULTI
    for (int p = 0; p < N_PHASES; ++p) { a.ph_lo = p; a.ph_hi = p + 1; hipLaunchKernelGGL(fwd_kernel, dim3(grid), dim3(NTHREADS), LDS_BYTES, stream, a); }
#else
    a.ph_lo = 0; a.ph_hi = N_PHASES;
    hipLaunchKernelGGL(fwd_kernel, dim3(grid), dim3(NTHREADS), LDS_BYTES, stream, a);
#endif
    const hipError_t le = hipPeekAtLastError();
    if (le != hipSuccess) fprintf(stderr, "kernel_launch: launch failed: %s\n", hipGetErrorName(le));
}
```

```cpp
#include <hip/hip_runtime.h>
#include <cstdio>
#include <cstdint>
__device__ __forceinline__ int ltid() { int t = (int)threadIdx.x; asm volatile("" : "+v"(t)); return t; }
#ifndef PG8_WGM
#define PG8_WGM 8
#endif
namespace pg8 {
#define PG8_LAS __attribute__((address_space(3)))
typedef unsigned short bf16_t;
typedef short bf16x8 __attribute__((ext_vector_type(8)));
typedef float f32x4 __attribute__((ext_vector_type(4)));
typedef unsigned u32x4 __attribute__((ext_vector_type(4)));
constexpr int BM = 256, BK = 64, HALF = 128, HTB = HALF * BK * 2  , STAGE_BYTES = 8 * HTB, NXCD = 8, WGM = PG8_WGM;

__host__ __device__ __forceinline__ int lds_byte(int r, int c) { const int st = (r >> 4) * 2 + (c >> 5), rr = r & 15, cc = c & 31, ob = rr * 64 + cc * 2; return st * 1024 + (ob ^ (((ob >> 9) & 1) << 5)); }
__host__ __device__ __forceinline__ void stage_rc(int b, int& R, int& C) { const int st = b / 1024, sb = b % 1024, swz = sb ^ (((sb >> 9) & 1) << 5); R = (st >> 1) * 16 + swz / 64; C = (st & 1) * 32 + (swz % 64) / 2; }
__host__ __device__ __forceinline__ int perm32(int rho) { const int n = rho >> 4, i = rho & 15; return 8 * (i >> 2) + 4 * n + (i & 3); }

struct Unit { int pm, pn; int k0 = 0, nk = 0, part = 0; };
struct Gemm { const bf16_t* A; const bf16_t* Bt; int M, N, K; int lda = 0; };

struct StaticOrder {
    int nM, nN, nwg, G, c;
    __host__ __device__ void init(int M, int N, int G_, int c_) { nM = M / BM; nN = N / BM; nwg = nM * nN; G = G_; c = c_; }
    __host__ __device__ bool next(int i, Unit& u) const {
        const long L = (long)i * G + c; if (L >= nwg) return false;
        int wgid = (int)L; { const int q = nwg / NXCD, r = nwg % NXCD, xcd = wgid % NXCD, off = wgid / NXCD; wgid = (xcd < r ? xcd * (q + 1) : r * (q + 1) + (xcd - r) * q) + off; }
        const int nig = WGM * nN, gid = wgid / nig, fm = gid * WGM, gsz = (nM - fm) < WGM ? (nM - fm) : WGM;
        u.pm = fm + ((wgid % nig) % gsz); u.pn = (wgid % nig) / gsz; return true;
    }
    __device__ __forceinline__ void a_ready(const Unit&) const {}
    __device__ __forceinline__ void done(const Unit&) const {}
};

typedef __attribute__((address_space(1))) unsigned gflag_t;
template <int NT, int KT, int CA, int CB, int CC, int LEADPOS_ = -1>
struct SplitOrder {
    static constexpr int R = NT % 4, NFULL = NT / 4, LEADPOS = LEADPOS_ < 0 ? NFULL - 1 : LEADPOS_;
    static_assert((R == 2 || R == 3) && CA % 2 == 0 && CB % 2 == 0 && CC % 2 == 0 && CA >= 2 && CA <= KT - 2 && KT % 2 == 0, "split shape");
    int c; unsigned char* slab; gflag_t* flags; gflag_t* tmo;
    __device__ __forceinline__ bool next(int i, Unit& u) const {
        const int j = c >> 6; int idx = i; int pm_ = ((c & 7) << 3) + ((c >> 3) & 7); asm volatile("" : "+s"(pm_));
        u.pm = pm_; u.k0 = 0; u.nk = KT; u.part = 0;
        const int lead_nk = R == 2 ? ((j & 1) ? 0 : CA) : (j == 0 ? CA : j == 1 ? CB : j == 2 ? CC : 0);
        const int lead_pn = 4 * NFULL + (R == 2 ? (j >> 1) : j);
        const int tail_k0 = R == 2 ? ((j & 1) ? CA : 0) : (j == 1 ? CA : j == 2 ? CB : j == 3 ? CC : 0);
        const int tail_pn = 4 * NFULL + (R == 2 ? (j >> 1) : j - 1);
        if (lead_nk) { if (idx == LEADPOS) { u.pn = lead_pn; u.nk = lead_nk; u.part = 1; return true; } if (idx > LEADPOS) --idx; }
        if (idx < NFULL) { u.pn = 4 * idx + j; return true; }
        if (idx == NFULL && tail_k0) { u.pn = tail_pn; u.k0 = tail_k0; u.nk = KT - tail_k0; u.part = 2; return true; }
        return false; }
    __device__ __forceinline__ int slot(const Unit& u) const { return u.pm * R + (u.pn - 4 * NFULL); }
    __device__ __forceinline__ void a_ready(const Unit&) const {}
    __device__ __forceinline__ void done(const Unit&) const {}
};
__device__ __forceinline__ unsigned cvt_pk_bf16(float lo, float hi) { unsigned r; asm volatile("v_cvt_pk_bf16_f32 %0, %1, %2" : "=v"(r) : "v"(lo), "v"(hi)); return r; }
template <class Epi, bool ON> struct AccInitRegs { typedef int type; };
template <class Epi> struct AccInitRegs<Epi, true> { typedef typename Epi::ResTile type; };
template <class Epi, class Sched, bool ALIGN_EPI = false, bool SP2 = false, int KREV = 0, int SPLITK = 0>
__device__ __forceinline__ void gemm_phase(PG8_LAS unsigned char* lds, const Gemm g, const Sched& S, const Epi& E) {
    const int tid = ltid(), wid = __builtin_amdgcn_readfirstlane(tid >> 6), lane = tid & 63, wr = wid >> 2, wc = wid & 3, fr = lane & 15, fq = lane >> 4;
    static_assert(!SPLITK || (ALIGN_EPI && KREV == 0 && !Epi::AFTER_DRAIN), "SPLITK needs ALIGN_EPI, KREV = 0, an in-stream epilogue");
    const int K = g.K, nt = K / BK, LDA = g.lda ? g.lda : K;
    unsigned voffA[2], voffB[2];
#pragma unroll
    for (int i = 0; i < 2; ++i) { int R, C; stage_rc(tid * 16 + i * 8192, R, C); const int Rb = Epi::PERM ? ((R & ~31) + perm32(R & 31)) : R;
        voffA[i] = (unsigned)(R * LDA + C) * 2u; voffB[i] = (unsigned)(Rb * K + C) * 2u; }
    const size_t kstep = (size_t)(BK * 2);
    const size_t hstep = (size_t)HALF * K * 2;
    const size_t tstep = 2 * hstep;
    const size_t hstepA = (size_t)HALF * LDA * 2, tstepA = 2 * hstepA;
    const unsigned ldsw = (unsigned)wid * 1024u;
    const int aoff = lds_byte(wr * 64 + fr, fq * 8), boff = lds_byte(wc * 32 + fr, fq * 8);
#define PG8_SA(b, h) (((b) * 2 + (h)) * HTB)
#define PG8_SB(b, h) ((4 + (b) * 2 + (h)) * HTB)
#define PG8_STAGE(bufoff, gbase, voff) do { _Pragma("unroll") for (int _i = 0; _i < 2; ++_i) \
        __builtin_amdgcn_global_load_lds((const unsigned*)((const char*)(gbase) + (voff)[_i]), (PG8_LAS unsigned*)(lds + (bufoff) + ldsw + _i * 8192), 16, 0, 0); } while (0)
#define PG8_LDA(dst, b, h) do { _Pragma("unroll") for (int m = 0; m < 4; ++m) _Pragma("unroll") for (int k = 0; k < 2; ++k) dst[m][k] = *(const PG8_LAS bf16x8*)(lds + PG8_SA(b, h) + aoff + m * 2048 + k * 1024); } while (0)
#define PG8_LDB(dst, b, h) do { _Pragma("unroll") for (int n = 0; n < 2; ++n) _Pragma("unroll") for (int k = 0; k < 2; ++k) dst[n][k] = *(const PG8_LAS bf16x8*)(lds + PG8_SB(b, h) + boff + n * 2048 + k * 1024); } while (0)
#define PG8_MMA(ai, bj, At, Bt) do { __builtin_amdgcn_s_setprio(1); _Pragma("unroll") for (int m = 0; m < 4; ++m) _Pragma("unroll") for (int n = 0; n < 2; ++n) _Pragma("unroll") for (int k = 0; k < 2; ++k) \
        acc[ai][bj][m][n] = __builtin_amdgcn_mfma_f32_16x16x32_bf16(Bt[n][k], At[m][k], acc[ai][bj][m][n], 0, 0, 0); __builtin_amdgcn_s_setprio(0); } while (0)
#define PG8_WAIT_V(n) asm volatile("s_waitcnt vmcnt(" #n ")" ::: "memory")
#define PG8_WAIT_L(n) asm volatile("s_waitcnt lgkmcnt(" #n ")" ::: "memory")
#define PG8_BAR __builtin_amdgcn_s_barrier()
#define PG8_SCHED __builtin_amdgcn_sched_barrier(0)
    Unit cur, nxt; int ui = 0;
    if (!S.next(0, cur)) return;
    f32x4 acc[2][2][4][2];
#pragma unroll
    for (int a = 0; a < 2; ++a)
#pragma unroll
        for (int b = 0; b < 2; ++b)
#pragma unroll
            for (int m = 0; m < 4; ++m)
#pragma unroll
                for (int n = 0; n < 2; ++n) acc[a][b][m][n] = (f32x4){0.f, 0.f, 0.f, 0.f};
    bf16x8 At[4][2], B0[2][2], B1[2][2];
    long cs = (KREV && ((ui & 1) == 0)) ? -(long)kstep : (long)kstep;
    int cnt = nt; if constexpr (SPLITK) cnt = cur.nk;
    const char* cA = (const char*)g.A + (size_t)cur.pm * tstepA + (cs < 0 ? (size_t)(nt - 1) * kstep : 0) + (SPLITK ? (size_t)cur.k0 * kstep : 0); const char* cB = (const char*)g.Bt + (size_t)cur.pn * tstep + (cs < 0 ? (size_t)(nt - 1) * kstep : 0) + (SPLITK ? (size_t)cur.k0 * kstep : 0);
    S.a_ready(cur);
    typename AccInitRegs<Epi, Epi::ACC_INIT>::type RR;
    if constexpr (Epi::ACC_INIT) E.prefetch(cur, wr, wc, fr, fq, RR);
    if constexpr (SP2) {
        PG8_STAGE(PG8_SB(0, 0), cB, voffB); PG8_STAGE(PG8_SB(0, 1), cB + hstep, voffB); PG8_STAGE(PG8_SA(0, 0), cA, voffA); PG8_STAGE(PG8_SA(0, 1), cA + hstepA, voffA);
        if (wr == 1) PG8_BAR;
        PG8_WAIT_V(2); PG8_BAR;
        PG8_STAGE(PG8_SB(1, 0), cB + cs, voffB); PG8_STAGE(PG8_SA(1, 0), cA + cs, voffA); PG8_STAGE(PG8_SB(1, 1), cB + hstep + cs, voffB);
        PG8_WAIT_V(6); PG8_BAR;
    } else {
        PG8_STAGE(PG8_SB(0, 0), cB, voffB); PG8_STAGE(PG8_SA(0, 0), cA, voffA); PG8_STAGE(PG8_SB(0, 1), cB + hstep, voffB); PG8_STAGE(PG8_SA(0, 1), cA + hstepA, voffA);
        if (wr == 1) PG8_BAR;
        PG8_WAIT_V(4); PG8_BAR;
        PG8_STAGE(PG8_SB(1, 0), cB + cs, voffB); PG8_STAGE(PG8_SA(1, 0), cA + cs, voffA); PG8_STAGE(PG8_SB(1, 1), cB + hstep + cs, voffB);
        PG8_WAIT_V(6); PG8_BAR;
    }
    if constexpr (Epi::ACC_INIT) E.init(acc, RR, cur, wr, wc, fr, fq);
    for (;;) {
        const bool has_next = S.next(ui + 1, nxt);
        const long ns = has_next ? ((KREV && (((ui + 1) & 1) == 0)) ? -(long)kstep : (long)kstep) : cs;
        const char* nA = has_next ? (const char*)g.A + (size_t)nxt.pm * tstepA + (ns < 0 ? (size_t)(nt - 1) * kstep : 0) + (SPLITK ? (size_t)nxt.k0 * kstep : 0) : cA; const char* nB = has_next ? (const char*)g.Bt + (size_t)nxt.pn * tstep + (ns < 0 ? (size_t)(nt - 1) * kstep : 0) + (SPLITK ? (size_t)nxt.k0 * kstep : 0) : cB;
        int ncnt = cnt; if constexpr (SPLITK) { if (has_next) ncnt = nxt.nk; }
        for (int t = 0; t < cnt; t += 2) {
            const bool last = (t == cnt - 2);
            const char* a1 = cA + (long)(t + 1) * cs;
            const char* a2 = last ? nA : cA + (long)(t + 2) * cs; const char* b2 = last ? nB : cB + (long)(t + 2) * cs;
            const long s3 = last ? ns : cs; const char* a3 = a2 + s3; const char* b3 = b2 + s3;
            if (last && has_next) S.a_ready(nxt);
            if constexpr (SP2) {
            PG8_LDB(B0, 0, 0); PG8_LDB(B1, 0, 1); PG8_SCHED; PG8_LDA(At, 0, 0); PG8_STAGE(PG8_SA(1, 1), a1 + hstepA, voffA);
            PG8_WAIT_V(8); PG8_WAIT_L(0); PG8_BAR; PG8_MMA(0, 0, At, B0); PG8_MMA(0, 1, At, B1); PG8_BAR; PG8_SCHED;
            PG8_LDA(At, 0, 1); PG8_STAGE(PG8_SB(0, 0), b2, voffB); PG8_STAGE(PG8_SB(0, 1), b2 + hstep, voffB); PG8_STAGE(PG8_SA(0, 0), a2, voffA);
            PG8_WAIT_V(8); PG8_WAIT_L(0); PG8_BAR; PG8_MMA(1, 0, At, B0); PG8_MMA(1, 1, At, B1); PG8_BAR; PG8_SCHED;
            PG8_LDB(B0, 1, 0); PG8_LDB(B1, 1, 1); PG8_SCHED; PG8_LDA(At, 1, 0); PG8_STAGE(PG8_SA(0, 1), a2 + hstepA, voffA);
            PG8_WAIT_V(8); PG8_WAIT_L(0); PG8_BAR; PG8_MMA(0, 0, At, B0); PG8_MMA(0, 1, At, B1); PG8_BAR; PG8_SCHED;
            PG8_LDA(At, 1, 1); PG8_STAGE(PG8_SB(1, 0), b3, voffB); PG8_STAGE(PG8_SB(1, 1), b3 + hstep, voffB); PG8_STAGE(PG8_SA(1, 0), a3, voffA);
            PG8_WAIT_V(8); PG8_WAIT_L(0); PG8_BAR; PG8_MMA(1, 0, At, B0); PG8_MMA(1, 1, At, B1); PG8_BAR; PG8_SCHED;
            } else {
            PG8_LDB(B0, 0, 0); PG8_SCHED; PG8_LDA(At, 0, 0); PG8_STAGE(PG8_SA(1, 1), a1 + hstepA, voffA);
            PG8_WAIT_L(8); PG8_BAR; PG8_WAIT_L(0); PG8_MMA(0, 0, At, B0); PG8_BAR; PG8_SCHED;
            PG8_LDB(B1, 0, 1); PG8_STAGE(PG8_SB(0, 0), b2, voffB);
            PG8_BAR; PG8_WAIT_L(0); PG8_MMA(0, 1, At, B1); PG8_BAR;
            PG8_LDA(At, 0, 1); PG8_STAGE(PG8_SA(0, 0), a2, voffA);
            PG8_BAR; PG8_WAIT_L(0); PG8_MMA(1, 0, At, B0); PG8_BAR; PG8_SCHED;
            PG8_STAGE(PG8_SB(0, 1), b2 + hstep, voffB);
            PG8_WAIT_V(6); PG8_BAR; PG8_MMA(1, 1, At, B1); PG8_BAR;
            PG8_LDB(B0, 1, 0); PG8_SCHED; PG8_LDA(At, 1, 0); PG8_STAGE(PG8_SA(0, 1), a2 + hstepA, voffA);
            PG8_WAIT_L(8); PG8_BAR; PG8_WAIT_L(0); PG8_MMA(0, 0, At, B0); PG8_BAR; PG8_SCHED;
            PG8_LDB(B1, 1, 1); PG8_STAGE(PG8_SB(1, 0), b3, voffB);
            PG8_BAR; PG8_WAIT_L(0); PG8_MMA(0, 1, At, B1); PG8_BAR;
            PG8_LDA(At, 1, 1); PG8_STAGE(PG8_SA(1, 0), a3, voffA);
            PG8_BAR; PG8_WAIT_L(0); PG8_MMA(1, 0, At, B0); PG8_BAR; PG8_SCHED;
            PG8_STAGE(PG8_SB(1, 1), b3 + hstep, voffB);
            PG8_WAIT_V(6); PG8_BAR; PG8_MMA(1, 1, At, B1); PG8_BAR;
            }
        }
        if constexpr (ALIGN_EPI) { if (wr == 0) PG8_BAR; }
        if constexpr (Epi::ACC_INIT) { if (has_next) E.prefetch(nxt, wr, wc, fr, fq, RR); }
        if constexpr (SPLITK) {
            if (cur.part == 1) {
                const __amdgpu_buffer_rsrc_t rs_ = __builtin_amdgcn_make_buffer_rsrc((void*)(S.slab + (size_t)S.slot(cur) * 262144), (short)0, 262144, 0x00020000);
#pragma unroll
                for (int q = 0; q < 32; ++q) __builtin_amdgcn_raw_buffer_store_b128(__builtin_bit_cast(u32x4, acc[q >> 4][(q >> 3) & 1][(q >> 1) & 3][q & 1]), rs_, (unsigned)tid * 16u, q * 8192,   16);
                asm volatile("s_waitcnt vmcnt(0)" ::: "memory"); PG8_BAR;
                if (tid == 0) __hip_atomic_store(S.flags + (S.slot(cur) << 4), 1u, __ATOMIC_RELAXED, __HIP_MEMORY_SCOPE_AGENT);
            } else {
                E(acc, cur, wr, wc, fr, fq);
            }
            S.done(cur);
        } else
        if constexpr (!Epi::AFTER_DRAIN) { E(acc, cur, wr, wc, fr, fq);
#if defined(REP_EPI)
            if constexpr (Epi::REPEATABLE) E(acc, cur, wr, wc, fr, fq);
#endif
            S.done(cur); }
        if (!has_next) break;
        bool from_slab = false;
        if constexpr (SPLITK) from_slab = nxt.part == 2;
        if (from_slab) {
            if constexpr (SPLITK) {
                if (tid == 0) { unsigned sp_ = 0;
                    while (__hip_atomic_load(S.flags + (S.slot(nxt) << 4), __ATOMIC_RELAXED, __HIP_MEMORY_SCOPE_AGENT) == 0u) { __builtin_amdgcn_s_sleep(1);
                        if ((++sp_ & 255u) == 0u) { if (__hip_atomic_load(S.tmo, __ATOMIC_RELAXED, __HIP_MEMORY_SCOPE_AGENT)) break;
                            if (sp_ > (1u << 21)) { __hip_atomic_fetch_add(S.tmo, 1u, __ATOMIC_RELAXED, __HIP_MEMORY_SCOPE_AGENT); break; } } } }
                PG8_BAR;
                const __amdgpu_buffer_rsrc_t rs_ = __builtin_amdgcn_make_buffer_rsrc((void*)(S.slab + (size_t)S.slot(nxt) * 262144), (short)0, 262144, 0x00020000);
                float one_ = 1.0f; asm volatile("" : "+v"(one_));
#pragma unroll
                for (int q = 0; q < 32; ++q) acc[q >> 4][(q >> 3) & 1][(q >> 1) & 3][q & 1] = __builtin_bit_cast(f32x4, __builtin_amdgcn_raw_buffer_load_b128(rs_, (unsigned)tid * 16u, q * 8192,   16)) * one_;
            }
        } else if constexpr (Epi::ACC_INIT) { E.init(acc, RR, nxt, wr, wc, fr, fq);
        } else {
#pragma unroll
        for (int a = 0; a < 2; ++a)
#pragma unroll
            for (int b = 0; b < 2; ++b)
#pragma unroll
                for (int m = 0; m < 4; ++m)
#pragma unroll
                    for (int n = 0; n < 2; ++n) acc[a][b][m][n] = (f32x4){0.f, 0.f, 0.f, 0.f};
        }
        cur = nxt; cA = nA; cB = nB; cs = ns; cnt = ncnt; ++ui;
        if constexpr (ALIGN_EPI) { if (wr == 1) PG8_BAR; }
    }
    PG8_WAIT_V(0);
    if constexpr (!ALIGN_EPI) { if (wr == 0) PG8_BAR; }
    PG8_BAR;
    if constexpr (Epi::AFTER_DRAIN) { E.fused(acc, cur, wr, wc, fr, fq, lds, wid, lane); S.done(cur); }
#undef PG8_SA
#undef PG8_SB
#undef PG8_STAGE
#undef PG8_LDA
#undef PG8_LDB
#undef PG8_MMA
#undef PG8_WAIT_V
#undef PG8_WAIT_L
#undef PG8_BAR
#undef PG8_SCHED
}
}
#define GAS __attribute__((address_space(1)))
#define LAS __attribute__((address_space(3)))
typedef unsigned short bf16;
typedef unsigned v4u __attribute__((ext_vector_type(4)));
typedef float f32x4 __attribute__((ext_vector_type(4)));
typedef short bf16x8 __attribute__((ext_vector_type(8)));
typedef GAS unsigned gu32;
typedef GAS unsigned long long gu64;
#define RLX_AGENT __ATOMIC_RELAXED, __HIP_MEMORY_SCOPE_AGENT
#define LDS_WAIT() asm volatile("s_waitcnt lgkmcnt(0)" ::: "memory")
#define VM_WAIT() asm volatile("s_waitcnt vmcnt(0)" ::: "memory")
__device__ __forceinline__ unsigned long long rt() { return __builtin_amdgcn_s_memrealtime(); }

#define XB_TMO      128
#define XB_XCNT(j)  (256  + 64 * (j))
#define XB_XSUB(j)  (1280 + 64 * (j))
#define XB_XGEN(j)  (2304 + 64 * (j))
#define XB_TOP      3328
#define XB_TOPGEN   3392
#define XCD_BAR_WORDS 3456
#define XB_SPIN_CAP (1u << 21)

__device__ __forceinline__ unsigned xb_ld(unsigned* p)              { return __hip_atomic_load(p, __ATOMIC_RELAXED, __HIP_MEMORY_SCOPE_AGENT); }
__device__ __forceinline__ unsigned xb_add(unsigned* p, unsigned v) { return __hip_atomic_fetch_add(p, v, __ATOMIC_RELAXED, __HIP_MEMORY_SCOPE_AGENT); }
__device__ __forceinline__ unsigned xb_xcc_id() { return (unsigned)__builtin_amdgcn_s_getreg((3 << 11) | 20) & 0xFu; }
#define XB_SPIN(cond, bar) do { unsigned _sp = 0; while (cond) { __builtin_amdgcn_s_sleep(1); \
    if ((++_sp & 255u) == 0u) { if (xb_ld(&(bar)[XB_TMO])) break; if (_sp > XB_SPIN_CAP) { atomicAdd(&(bar)[XB_TMO], 1u); break; } } } } while (0)

struct XcdBarrier {
    unsigned* bar; unsigned x;
    volatile LAS unsigned* st;
};

__device__ __forceinline__ XcdBarrier xcd_barrier_post(unsigned* bar, volatile LAS unsigned* st) {
    XcdBarrier b; b.bar = bar; b.x = xb_xcc_id(); b.st = st;
    if (threadIdx.x == 0) (void)xb_add(&bar[XB_XCNT(b.x)], 1u);
    return b;
}
__device__ __forceinline__ void xcd_barrier_complete(unsigned* bar, unsigned x, unsigned& nloc, unsigned& nx) {
    const unsigned G = gridDim.x * gridDim.y * gridDim.z;
    unsigned sum, cnt, mine, sp = 0u;
    for (;;) {
        sum = 0u; cnt = 0u; mine = 0u;
#pragma unroll
        for (unsigned j = 0; j < 16; ++j) { const unsigned c = xb_ld(&bar[XB_XCNT(j)]); sum += c; cnt += (c > 0u) ? 1u : 0u; mine = (j == x) ? c : mine; }
        if (sum == G) break;
        __builtin_amdgcn_s_sleep(1);
        if ((++sp & 255u) == 0u) { if (xb_ld(&bar[XB_TMO])) break; if (sp > XB_SPIN_CAP) { atomicAdd(&bar[XB_TMO], 1u); break; } }
    }
    nloc = mine > 0u ? mine : 1u; nx = cnt > 0u ? cnt : 1u;
}

__device__ __forceinline__ void xcd_barrier(const XcdBarrier& b) {
    asm volatile("s_waitcnt vmcnt(0)" ::: "memory");
    __syncthreads();
    if (threadIdx.x == 0) {
        unsigned* bar = b.bar;
        __builtin_amdgcn_s_waitcnt(0);
        unsigned nloc = b.st[0], nx = b.st[1];
        if (nloc == 0u) { xcd_barrier_complete(bar, b.x, nloc, nx); b.st[0] = nloc; b.st[1] = nx; }
        const unsigned old = xb_add(&bar[XB_XSUB(b.x)], 1u);
        const unsigned gen = old / nloc;
        if (old + 1u == (gen + 1u) * nloc) {
            __builtin_amdgcn_fence(__ATOMIC_RELEASE, "agent");
            asm volatile("s_waitcnt vmcnt(0)" ::: "memory");
            const unsigned og = xb_add(&bar[XB_TOP], 1u);
            const unsigned tg = og / nx;
            if (og + 1u == (tg + 1u) * nx) xb_add(&bar[XB_TOPGEN], 1u);
            else XB_SPIN(xb_ld(&bar[XB_TOPGEN]) == tg, bar);
            __builtin_amdgcn_fence(__ATOMIC_ACQUIRE, "agent");
            xb_add(&bar[XB_XGEN(b.x)], 1u);
            asm volatile("s_waitcnt vmcnt(0)" ::: "memory");
        } else {
            XB_SPIN(xb_ld(&bar[XB_XGEN(b.x)]) == gen, bar);
            __builtin_amdgcn_fence(__ATOMIC_ACQUIRE, "agent");
            asm volatile("s_waitcnt vmcnt(0)" ::: "memory");
        }
    }
    __syncthreads();
}

#define DI __device__ __forceinline__
typedef float f32x2 __attribute__((ext_vector_type(2)));
typedef __bf16 bf16x2_t __attribute__((ext_vector_type(2)));
typedef float f32x16 __attribute__((ext_vector_type(16)));
typedef short s16x4 __attribute__((ext_vector_type(4)));
constexpr int NWAVES = 8, NTHREADS = 512;
constexpr int BATCH = 4, SEQ = 4096, M = BATCH * SEQ, D = 2048, F = 5504, NGU = 2 * F, NL = 4;
constexpr int PIN = 5440, PINP = 5632;
constexpr int HP = PINP;
constexpr int HGW = 768, UQN = 1152, UKVN = 1536;
constexpr float EPS = 1e-6f;
constexpr float LOG2E = 1.4426950408889634f;
constexpr int C_HQ = 0, C_HF = 768, C_HI = 1536, C_HG = 2304, C_DQ = 3072, C_DK = 3584, C_DV = 4096, C_CQ = 4608, C_CKV = 5120, C_KR = 5376;
constexpr int MX_HG = 0, MX_DF = 768, MX_ML = 1280;
constexpr float SC_HQ = 0.08838834764831845f;
constexpr float SC_DQ = 0.125f * LOG2E;
constexpr float SC_MQ = 0.07216878364870322f * LOG2E;

constexpr size_t MiB = 1u << 20;
constexpr size_t WS_CTL = 0, CTL_ZERO_BYTES = 1 * MiB;
constexpr size_t WS_CONST = 1 * MiB;
constexpr size_t CO_LB = 0, CO_LAM = 16384, CO_BIAS = 20480, CO_ROPE = 65536;
constexpr size_t WS_W = 4 * MiB;
constexpr size_t SZ_GU = (size_t)NGU * D * 2, SZ_DN = (size_t)D * F * 2, SZ_IN = (size_t)PINP * D * 2, SZ_OUT = (size_t)D * D * 2, SZ_UQ = (size_t)UQN * 512 * 2, SZ_UKV = (size_t)UKVN * 256 * 2;
constexpr size_t WO_GUA = 0, WO_DA = WO_GUA + SZ_GU, WO_IN = WO_DA + SZ_DN, WO_OUT = WO_IN + SZ_IN, WO_UQ = WO_OUT + SZ_OUT, WO_UKV = WO_UQ + SZ_UQ, WO_GUB = WO_UKV + SZ_UKV, WO_DB = WO_GUB + SZ_GU, W_LAYER = WO_DB + SZ_DN;
constexpr size_t WS_XB = WS_W + NL * W_LAYER;
constexpr size_t WS_STATS = WS_XB + (size_t)M * D * 2;
constexpr size_t WS_A = WS_STATS + (size_t)M * 32 * 4;
constexpr size_t WS_LF = WS_A + (size_t)M * PINP * 2;
constexpr size_t WS_QI = WS_LF + (size_t)M * HGW * 4;
constexpr size_t WS_P = WS_QI + (size_t)M * HGW * 2;
constexpr size_t WS_KDT = WS_P + (size_t)1536 * 4096 * 2;
constexpr size_t WS_VT = WS_KDT + (size_t)M * HGW * 2;
constexpr size_t WS_DEC = WS_VT + (size_t)M * HGW * 2;
constexpr size_t WS_QM = WS_DEC + 1 * MiB;
constexpr size_t WS_KM = WS_QM + (size_t)M * UQN * 2;
constexpr size_t WS_VM = WS_KM + (size_t)M * UQN * 2;
constexpr size_t WS_QN = WS_VM + (size_t)M * 768 * 2;
constexpr size_t WS_KN = WS_QN + (size_t)M * 512 * 2;
constexpr size_t WS_SCR = WS_KN + (size_t)M * 512 * 2;
constexpr size_t WS_MIX = WS_SCR + (size_t)256 * 256 * 128 * 4;
constexpr size_t WS_XL = WS_MIX + (size_t)M * D * 2;
constexpr size_t WS_SLAB = WS_XL + (size_t)M * D * 2;
#ifndef SPLITK_SLABS
#define SPLITK_SLABS 0
#endif
constexpr size_t WS_END = WS_SLAB + (size_t)SPLITK_SLABS * 262144;
static_assert(WS_XB % 256 == 0 && WS_A % 256 == 0 && WS_QM % 256 == 0 && WS_MIX % 256 == 0, "ws map alignment");
constexpr int CW_BAR = 4096;
constexpr int CW_Q = 16384;
constexpr int CW_XCC = 49152, CW_NONLOCAL = 49152 + 512;
constexpr int CW_SPL = 65536;
static_assert((size_t)(CW_SPL + 12 * 192 * 16) * 4 <= CTL_ZERO_BYTES, "flag words inside the per-call memset");

constexpr int LDSCTL_OFF = 0, MISC_OFF = 320, RING_OFF = 1024, LDS_BYTES = 147456, RING_BYTES = LDS_BYTES - RING_OFF;

DI unsigned pk2(float lo, float hi) { f32x2 v = {lo, hi}; bf16x2_t b = __builtin_convertvector(v, bf16x2_t); return __builtin_bit_cast(unsigned, b); }
DI float bflo(unsigned w) { return __uint_as_float(w << 16); }
DI float bfhi(unsigned w) { return __uint_as_float(w & 0xffff0000u); }
DI float bf2f(unsigned short b) { return __uint_as_float(((unsigned)b) << 16); }
DI float wave_sum(float v) {
#pragma unroll
    for (int o = 1; o < 64; o <<= 1) v += __shfl_xor(v, o);
    return v;
}
DI float ex2(float x) { return __builtin_amdgcn_exp2f(x); }
DI float fexp(float x) { return __builtin_amdgcn_exp2f(x * LOG2E); }
DI float fsigmoid(float x) { return __builtin_amdgcn_rcpf(1.f + fexp(-x)); }
DI float frsqrt(float x) { return __builtin_amdgcn_rsqf(x); }
DI bf16x8 mk8(unsigned a, unsigned b, unsigned c, unsigned d) { v4u w = {a, b, c, d}; return __builtin_bit_cast(bf16x8, w); }
DI f32x4 mfma16(bf16x8 a, bf16x8 b, f32x4 c) { return __builtin_amdgcn_mfma_f32_16x16x32_bf16(a, b, c, 0, 0, 0); }

DI void load_rs(const float* stats, int row0, int fq, float (&rs)[2][4]) {
#pragma unroll
    for (int ai = 0; ai < 2; ++ai)
#pragma unroll
        for (int m = 0; m < 4; ++m) { const f32x4* p = (const f32x4*)(stats + (size_t)(row0 + ai * 128 + m * 16) * 32 + 8 * fq); const f32x4 a = p[0], b = p[1];
            float s = ((a[0] + a[1]) + (a[2] + a[3])) + ((b[0] + b[1]) + (b[2] + b[3])); s += __shfl_xor(s, 16); s += __shfl_xor(s, 32); rs[ai][m] = frsqrt(s * (1.0f / D) + EPS); }
}
#ifndef H_NT
#define H_NT 0
#endif
struct EpiSwiGLU {
    static constexpr bool PERM = true, AFTER_DRAIN = false, REPEATABLE = false, ACC_INIT = false;
    bf16* H; const float* stats; mutable float rs[2][4]; mutable int last_pm;
    DI void operator()(const pg8::f32x4 (&acc)[2][2][4][2], const pg8::Unit& u, int wr, int wc, int fr, int fq) const {
        const int row0 = u.pm * 256 + wr * 64 + fr, col0 = u.pn * 128 + wc * 32 + 8 * fq;
        if (u.pm != last_pm) { load_rs(stats, row0, fq, rs); last_pm = u.pm; }
#pragma unroll
        for (int ai = 0; ai < 2; ++ai)
#pragma unroll
            for (int m = 0; m < 4; ++m) { const float r = rs[ai][m]; float hv[8];
#pragma unroll
                for (int n = 0; n < 2; ++n)
#pragma unroll
                    for (int j = 0; j < 4; ++j) { const float g = acc[ai][0][m][n][j] * r, up = acc[ai][1][m][n][j] * r; hv[4 * n + j] = g * fsigmoid(g) * up; }
                v4u w; w.x = pk2(hv[0], hv[1]); w.y = pk2(hv[2], hv[3]); w.z = pk2(hv[4], hv[5]); w.w = pk2(hv[6], hv[7]);
                if (H_NT) __builtin_nontemporal_store(w, (v4u*)(H + (size_t)(row0 + ai * 128 + m * 16) * HP + col0)); else *(v4u*)(H + (size_t)(row0 + ai * 128 + m * 16) * HP + col0) = w; }
    }
};
#ifndef RESID_LO
#define RESID_LO 0
#endif
#ifndef RES_AHEAD
#define RES_AHEAD 3
#endif
#ifndef RESID_ACC_INIT
#define RESID_ACC_INIT 0
#endif
#ifndef RESID_DEPTH
#define RESID_DEPTH 3
#endif
struct EpiResid {
    static constexpr bool PERM = true, AFTER_DRAIN = false, REPEATABLE = false, ACC_INIT = RESID_ACC_INIT;
    float* OUT; bf16* XB; bf16* XL; float* stats; float alpha; bool final;
    typedef v4u ResTile[RES_AHEAD][2];
    DI void prefetch(const pg8::Unit& u, int wr, int wc, int fr, int fq, ResTile& R) const {
        const int row0 = u.pm * 256 + wr * 64 + fr, col0 = u.pn * 256 + wc * 32 + 8 * fq;
        const __amdgpu_buffer_rsrc_t rx = __builtin_amdgcn_make_buffer_rsrc((void*)XB, (short)0, M * D * 2, 0x00020000);
        const unsigned voff = (unsigned)(row0 * D + col0) * 2u;
#pragma unroll
        for (int g = 0; g < RES_AHEAD; ++g)
#pragma unroll
            for (int bj = 0; bj < 2; ++bj) R[g][bj] = __builtin_amdgcn_raw_buffer_load_b128(rx, voff, (((g >> 2) * 128 + (g & 3) * 16) * D + bj * 128) * 2, 0);
    }
    DI void init(pg8::f32x4 (&acc)[2][2][4][2], const ResTile& R, const pg8::Unit& u, int wr, int wc, int fr, int fq) const {
        const float ia = 1.0f / alpha;
        const int row0 = u.pm * 256 + wr * 64 + fr, col0 = u.pn * 256 + wc * 32 + 8 * fq;
        const __amdgpu_buffer_rsrc_t rx = __builtin_amdgcn_make_buffer_rsrc((void*)XB, (short)0, M * D * 2, 0x00020000);
        const unsigned voff = (unsigned)(row0 * D + col0) * 2u;
        v4u R2[8 - RES_AHEAD][2];
#pragma unroll
        for (int g = RES_AHEAD; g < 8; ++g)
#pragma unroll
            for (int bj = 0; bj < 2; ++bj) R2[g - RES_AHEAD][bj] = __builtin_amdgcn_raw_buffer_load_b128(rx, voff, (((g >> 2) * 128 + (g & 3) * 16) * D + bj * 128) * 2, 0);
#pragma unroll
        for (int g = 0; g < 8; ++g)
#pragma unroll
            for (int bj = 0; bj < 2; ++bj) { v4u h; if (g < RES_AHEAD) h = R[g < RES_AHEAD ? g : 0][bj]; else h = R2[g >= RES_AHEAD ? g - RES_AHEAD : 0][bj];
                acc[g >> 2][bj][g & 3][0] = (pg8::f32x4){bflo(h.x) * ia, bfhi(h.x) * ia, bflo(h.y) * ia, bfhi(h.y) * ia};
                acc[g >> 2][bj][g & 3][1] = (pg8::f32x4){bflo(h.z) * ia, bfhi(h.z) * ia, bflo(h.w) * ia, bfhi(h.w) * ia}; }
    }
    DI void operator()(const pg8::f32x4 (&acc)[2][2][4][2], const pg8::Unit& u, int wr, int wc, int fr, int fq) const {
        const int row0 = u.pm * 256 + wr * 64 + fr, col0 = u.pn * 256 + wc * 32 + 8 * fq;
        if constexpr (ACC_INIT) {
            static_assert(!RESID_ACC_INIT || !RESID_LO, "ACC_INIT keeps the residual in bf16 only");
            const __amdgpu_buffer_rsrc_t rx = __builtin_amdgcn_make_buffer_rsrc((void*)XB, (short)0, M * D * 2, 0x00020000);
            const __amdgpu_buffer_rsrc_t ro = __builtin_amdgcn_make_buffer_rsrc((void*)OUT, (short)0, M * D * 4, 0x00020000);
            const unsigned voff = (unsigned)(row0 * D + col0) * 2u;
#pragma unroll
            for (int g = 0; g < 8; ++g) { const int ai = g >> 2, m = g & 3, row = row0 + ai * 128 + m * 16; float ss = 0.f;
#pragma unroll
                for (int bj = 0; bj < 2; ++bj) { const int so = ((ai * 128 + m * 16) * D + bj * 128) * 2;
                    const f32x4 x0 = acc[ai][bj][m][0] * alpha, x1 = acc[ai][bj][m][1] * alpha;
                    if (final) { __builtin_amdgcn_raw_buffer_store_b128(__builtin_bit_cast(v4u, x0), ro, voff * 2u, so * 2, 0); __builtin_amdgcn_raw_buffer_store_b128(__builtin_bit_cast(v4u, x1), ro, voff * 2u, so * 2 + 16, 0); }
                    else {
                        ss += (x0[0] * x0[0] + x0[1] * x0[1]) + (x0[2] * x0[2] + x0[3] * x0[3]) + (x1[0] * x1[0] + x1[1] * x1[1]) + (x1[2] * x1[2] + x1[3] * x1[3]);
                        v4u w; w.x = pk2(x0[0], x0[1]); w.y = pk2(x0[2], x0[3]); w.z = pk2(x1[0], x1[1]); w.w = pk2(x1[2], x1[3]);
                        __builtin_amdgcn_raw_buffer_store_b128(w, rx, voff, so, 0); } }
                if (!final) { ss += __shfl_xor(ss, 16); ss += __shfl_xor(ss, 32);
                    if (fq == 0) stats[(size_t)row * 32 + u.pn * 4 + wc] = ss; } }
            return;
        }
        v4u rh[RESID_DEPTH][2], rl[RESID_DEPTH][2];
#define RLOAD(buf, g) do { const size_t o_ = (size_t)(row0 + ((g) >> 2) * 128 + ((g) & 3) * 16) * D + col0; \
    rh[buf][0] = *(const v4u*)(XB + o_); rh[buf][1] = *(const v4u*)(XB + o_ + 128); if (RESID_LO) { rl[buf][0] = *(const v4u*)(XL + o_); rl[buf][1] = *(const v4u*)(XL + o_ + 128); } else { rl[buf][0] = rl[buf][1] = (v4u){0u, 0u, 0u, 0u}; } } while (0)
#pragma unroll
        for (int g = 0; g < RESID_DEPTH; ++g) RLOAD(g, g);
#pragma unroll
        for (int g = 0; g < 8; ++g) { const int ai = g >> 2, m = g & 3, row = row0 + ai * 128 + m * 16; float ss = 0.f;
            __builtin_amdgcn_sched_barrier(0);
#pragma unroll
            for (int bj = 0; bj < 2; ++bj) { const size_t off = (size_t)row * D + col0 + bj * 128;
                const v4u h = rh[g % RESID_DEPTH][bj], lo = rl[g % RESID_DEPTH][bj];
                f32x4 x0 = {bflo(h.x) + bflo(lo.x), bfhi(h.x) + bfhi(lo.x), bflo(h.y) + bflo(lo.y), bfhi(h.y) + bfhi(lo.y)};
                f32x4 x1 = {bflo(h.z) + bflo(lo.z), bfhi(h.z) + bfhi(lo.z), bflo(h.w) + bflo(lo.w), bfhi(h.w) + bfhi(lo.w)};
                x0 = x0 + acc[ai][bj][m][0] * alpha; x1 = x1 + acc[ai][bj][m][1] * alpha;
                if (final) { *(f32x4*)(OUT + off) = x0; *(f32x4*)(OUT + off + 4) = x1; }
                else {
                    ss += (x0[0] * x0[0] + x0[1] * x0[1]) + (x0[2] * x0[2] + x0[3] * x0[3]) + (x1[0] * x1[0] + x1[1] * x1[1]) + (x1[2] * x1[2] + x1[3] * x1[3]);
                    v4u w; w.x = pk2(x0[0], x0[1]); w.y = pk2(x0[2], x0[3]); w.z = pk2(x1[0], x1[1]); w.w = pk2(x1[2], x1[3]);
                    v4u l2; l2.x = pk2(x0[0] - bflo(w.x), x0[1] - bfhi(w.x)); l2.y = pk2(x0[2] - bflo(w.y), x0[3] - bfhi(w.y)); l2.z = pk2(x1[0] - bflo(w.z), x1[1] - bfhi(w.z)); l2.w = pk2(x1[2] - bflo(w.w), x1[3] - bfhi(w.w));
                    *(v4u*)(XB + off) = w; if (RESID_LO) *(v4u*)(XL + off) = l2; } }
            if (!final) { ss += __shfl_xor(ss, 16); ss += __shfl_xor(ss, 32);
                if (fq == 0) stats[(size_t)row * 32 + u.pn * 4 + wc] = ss; }
            __builtin_amdgcn_sched_barrier(0);
            if (g + RESID_DEPTH < 8) RLOAD(g % RESID_DEPTH, g + RESID_DEPTH); }
#undef RLOAD
    }
};
struct EpiProj {
    static constexpr bool PERM = true, AFTER_DRAIN = false, REPEATABLE = false, ACC_INIT = false;
    bf16* P; float* LF; const float* stats; const float* lb;
    mutable float rs[2][4]; mutable int last_pm;
    DI void operator()(const pg8::f32x4 (&acc)[2][2][4][2], const pg8::Unit& u, int wr, int wc, int fr, int fq) const {
        const int row0 = u.pm * 256 + wr * 64 + fr, col0 = u.pn * 256 + wc * 32 + 8 * fq;
        if (u.pm != last_pm) { load_rs(stats, row0, fq, rs); last_pm = u.pm; }
        const int seg = u.pn < 3 ? 0 : (u.pn < 6 ? 1 : (u.pn < 9 ? 2 : (u.pn < 12 ? 3 : 4)));
#pragma unroll
        for (int bj = 0; bj < 2; ++bj) { const int col = col0 + bj * 128;
            float lbv[8];
            if (seg == 1) { const f32x4 a = *(const f32x4*)(lb + col - C_HF), b = *(const f32x4*)(lb + col - C_HF + 4); lbv[0] = a[0]; lbv[1] = a[1]; lbv[2] = a[2]; lbv[3] = a[3]; lbv[4] = b[0]; lbv[5] = b[1]; lbv[6] = b[2]; lbv[7] = b[3]; }
            else {
#pragma unroll
                for (int j = 0; j < 8; ++j) lbv[j] = 0.f; }
#pragma unroll
            for (int ai = 0; ai < 2; ++ai)
#pragma unroll
                for (int m = 0; m < 4; ++m) { const int row = row0 + ai * 128 + m * 16; const float r = rs[ai][m]; float v[8];
#pragma unroll
                    for (int n = 0; n < 2; ++n)
#pragma unroll
                        for (int j = 0; j < 4; ++j) v[4 * n + j] = acc[ai][bj][m][n][j] * r;
                    if (seg == 0) {
#pragma unroll
                        for (int j = 0; j < 8; ++j) v[j] *= SC_HQ; }
                    else if (seg == 1) { float lf[8];
#pragma unroll
                        for (int j = 0; j < 8; ++j) { const float f = lbv[j] + (1.f - lbv[j]) * fsigmoid(v[j]); lf[j] = __builtin_amdgcn_logf(f) * 0.6931471805599453f; v[j] = 1.f - f; }
                        float* lp = LF + (size_t)row * HGW + col - C_HF; *(f32x4*)lp = (f32x4){lf[0], lf[1], lf[2], lf[3]}; *(f32x4*)(lp + 4) = (f32x4){lf[4], lf[5], lf[6], lf[7]}; }
                    else if (seg == 3) {
#pragma unroll
                        for (int j = 0; j < 8; ++j) v[j] = v[j] * fsigmoid(v[j]); }
                    v4u w; w.x = pk2(v[0], v[1]); w.y = pk2(v[2], v[3]); w.z = pk2(v[4], v[5]); w.w = pk2(v[6], v[7]);
                    *(v4u*)(P + (size_t)row * PINP + col) = w; }
        }
    }
};

#ifndef ATT_STAGGER
#define ATT_STAGGER 0
#endif
namespace att {
constexpr int KVBLK = 64, QBLK = 32, DV = 128;
constexpr int SHM_V = KVBLK * DV * 2;
constexpr float THR2 = 8.f * LOG2E;
template <int DQK> struct Cfg {
    static constexpr int KROW = DQK * 2 + 16, SHM_K = KVBLK * KROW, KCH = DQK / 64, CPR = DQK / 8;
    static constexpr int NSLOT = 3, OFF_V = 0, OFF_K = NSLOT * SHM_V, OFF_WS = OFF_K + NSLOT * SHM_K, OFF_BIAS = OFF_WS + NWAVES * 64 * 4, BYTES = OFF_BIAS + 1024;
};
static_assert(Cfg<192>::BYTES <= RING_BYTES, "attention LDS");
#define SBAR() __builtin_amdgcn_sched_barrier(0)
DI int crow(int r, int hi) { return (r & 3) + 8 * (r >> 2) + 4 * hi; }
DI unsigned cvtpk(float lo, float hi) { unsigned r; asm volatile("v_cvt_pk_bf16_f32 %0, %1, %2" : "=v"(r) : "v"(lo), "v"(hi)); return r; }
DI void partialSM(f32x16& p0, f32x16& p1, float& m_reg, float& mn, float& alpha) {
    float pmax = p0[0];
#pragma unroll
    for (int r = 1; r < 16; ++r) pmax = fmaxf(pmax, p0[r]);
#pragma unroll
    for (int r = 0; r < 16; ++r) pmax = fmaxf(pmax, p1[r]);
    { auto rr = __builtin_amdgcn_permlane32_swap(__float_as_uint(pmax), __float_as_uint(pmax), false, false);
      pmax = fmaxf(__uint_as_float(rr[0]), __uint_as_float(rr[1])); }
    if (__builtin_expect(__all(pmax - m_reg <= THR2), 1)) { mn = m_reg; alpha = 1.f; }
    else { mn = fmaxf(m_reg, pmax); alpha = ex2(m_reg - mn); m_reg = mn; }
#pragma unroll
    for (int r = 0; r < 16; ++r) { p0[r] -= mn; p1[r] -= mn; }
#pragma unroll
    for (int r = 0; r < 16; ++r) p0[r] = ex2(p0[r]);
}
DI void finishSM(f32x16& p0, f32x16& p1, float alpha, float& l_reg, bf16x8& pa0, bf16x8& pa1, bf16x8& pa2, bf16x8& pa3) {
#pragma unroll
    for (int r = 0; r < 16; ++r) p1[r] = ex2(p1[r]);
    float ps = 0;
#pragma unroll
    for (int r = 0; r < 16; ++r) ps += p0[r];
#pragma unroll
    for (int r = 0; r < 16; ++r) ps += p1[r];
    { auto rr = __builtin_amdgcn_permlane32_swap(__float_as_uint(ps), __float_as_uint(ps), false, false);
      ps = __uint_as_float(rr[0]) + __uint_as_float(rr[1]); }
    l_reg = l_reg * alpha + ps;
#define PK4(P, BASE, OUT) do { unsigned a0 = cvtpk(P[BASE + 0], P[BASE + 1]), a1 = cvtpk(P[BASE + 2], P[BASE + 3]);   \
    unsigned b0 = cvtpk(P[BASE + 4], P[BASE + 5]), b1 = cvtpk(P[BASE + 6], P[BASE + 7]);                              \
    auto r0 = __builtin_amdgcn_permlane32_swap(a0, b0, false, false); auto r1 = __builtin_amdgcn_permlane32_swap(a1, b1, false, false); \
    v4u w = {r0[0], r1[0], r0[1], r1[1]}; OUT = __builtin_bit_cast(bf16x8, w); } while (0)
    PK4(p0, 0, pa0); PK4(p0, 8, pa1); PK4(p1, 0, pa2); PK4(p1, 8, pa3);
#undef PK4
}
template <int DQK> DI void qkt(f32x16& p0, f32x16& p1, const LAS char* Ks, const bf16x8* qr, int r32, int hi) {
    constexpr int KROW = Cfg<DQK>::KROW;
    p0 = f32x16{}; p1 = f32x16{};
#pragma unroll
    for (int d0 = 0; d0 < DQK / 16; ++d0) { const int cb = (d0 * 16 + hi * 8) * 2;
        const bf16x8 b0 = *(const LAS bf16x8*)(Ks + r32 * KROW + cb);
        const bf16x8 b1 = *(const LAS bf16x8*)(Ks + (32 + r32) * KROW + cb);
        p0 = __builtin_amdgcn_mfma_f32_32x32x16_bf16(b0, qr[d0], p0, 0, 0, 0);
        p1 = __builtin_amdgcn_mfma_f32_32x32x16_bf16(b1, qr[d0], p1, 0, 0, 0); }
}
DI int v_st(int k, int c) { const int kk = (k & ~0xC) | ((k & 4) << 1) | ((k & 8) >> 1); return ((kk >> 3) * 4 + (c >> 5)) * 512 + ((kk & 7) * 32 + (c & 31)) * 2; }
DI int v_rd_base(int lane) { return ((lane & 3) << 3) | (((lane >> 2) & 3) << 6) | (((lane >> 4) & 1) << 5) | (((lane >> 5) & 1) << 8); }
constexpr int v_rd_off(int d0, int ks, int half) { return d0 * 512 + ks * 4096 + half * 2048; }
template <int OFF> DI s16x4 tr_read(int vb) { s16x4 r; asm volatile("ds_read_b64_tr_b16 %0, %1 offset:%2" : "=&v"(r) : "v"(vb), "i"(OFF) : "memory"); return r; }
template <int D0> DI void pv_one(f32x16& od, int vb, bf16x8 pa0, bf16x8 pa1, bf16x8 pa2, bf16x8 pa3) {
    const s16x4 l0 = tr_read<v_rd_off(D0, 0, 0)>(vb), h0 = tr_read<v_rd_off(D0, 0, 1)>(vb), l1 = tr_read<v_rd_off(D0, 1, 0)>(vb), h1 = tr_read<v_rd_off(D0, 1, 1)>(vb);
    const s16x4 l2 = tr_read<v_rd_off(D0, 2, 0)>(vb), h2 = tr_read<v_rd_off(D0, 2, 1)>(vb), l3 = tr_read<v_rd_off(D0, 3, 0)>(vb), h3 = tr_read<v_rd_off(D0, 3, 1)>(vb);
    asm volatile("s_waitcnt lgkmcnt(0)" ::: "memory"); SBAR();
#define PK(L, H) (bf16x8){L[0], L[1], L[2], L[3], H[0], H[1], H[2], H[3]}
    od = __builtin_amdgcn_mfma_f32_32x32x16_bf16(pa0, PK(l0, h0), od, 0, 0, 0);
    od = __builtin_amdgcn_mfma_f32_32x32x16_bf16(pa1, PK(l1, h1), od, 0, 0, 0);
    od = __builtin_amdgcn_mfma_f32_32x32x16_bf16(pa2, PK(l2, h2), od, 0, 0, 0);
    od = __builtin_amdgcn_mfma_f32_32x32x16_bf16(pa3, PK(l3, h3), od, 0, 0, 0);
#undef PK
}
DI void pv_d0(f32x16* o, int vb, bf16x8 pa0, bf16x8 pa1, bf16x8 pa2, bf16x8 pa3) {
    pv_one<0>(o[0], vb, pa0, pa1, pa2, pa3); pv_one<1>(o[1], vb, pa0, pa1, pa2, pa3); pv_one<2>(o[2], vb, pa0, pa1, pa2, pa3); pv_one<3>(o[3], vb, pa0, pa1, pa2, pa3);
}
template <int DQK, bool BIAS, int SDEPTH, int LDK, int LDV, bool QFIRST>
DI void attn_pass(LAS char* lds, const bf16* __restrict__ Qw, const bf16* __restrict__ Kh, const bf16* __restrict__ Vh,
                  int NT, int NTw, int bias_from, int bias_idx0, f32x16 (&o)[4], float& l_reg) {
    using C = Cfg<DQK>;
    constexpr int KROW = C::KROW, SHM_K = C::SHM_K, KCH = C::KCH, CPR = C::CPR;
    const int tid = ltid(), wid = __builtin_amdgcn_readfirstlane(tid >> 6), lane = tid & 63, r32 = lane & 31, hi = lane >> 5;
    LAS char* V_lds = lds + C::OFF_V; LAS char* K_lds = lds + C::OFF_K;
    LAS float* wsf = (LAS float*)(lds + C::OFF_WS) + wid * 64; LAS float* al_l = wsf + 32;
    const LAS float* btab = (const LAS float*)(lds + C::OFF_BIAS);
    float m_reg = -1e30f; l_reg = 0.f;
#pragma unroll
    for (int d = 0; d < 4; ++d) o[d] = f32x16{};
    bf16x8 qr[DQK / 16];
#pragma unroll
    for (int d0 = 0; d0 < DQK / 16; ++d0) qr[d0] = *(const bf16x8*)(Qw + d0 * 16);
#define KOFFS() unsigned kso[KCH], kdo[KCH], vso0, vso1; int vst0, vst1; { int t_ = tid; asm volatile("" : "+v"(t_)); const unsigned kr_ = (unsigned)t_ >> 3, kc_ = (unsigned)t_ & 7u; \
        _Pragma("unroll") for (int i_ = 0; i_ < KCH; ++i_) { kso[i_] = (kr_ * LDK + kc_ * 8u) * 2u + i_ * 128u; kdo[i_] = kr_ * KROW + kc_ * 16u + i_ * 128u; } \
        const int sr_i = t_ >> 4, sc_i = (t_ & 15) * 8; vso0 = (unsigned)(sr_i * LDV + sc_i) * 2u; vso1 = (unsigned)((32 + sr_i) * LDV + sc_i) * 2u; vst0 = v_st(sr_i, sc_i); vst1 = v_st(32 + sr_i, sc_i); }
    const int vb0 = (int)(unsigned)(uintptr_t)V_lds + v_rd_base(lane);
    struct { bf16x8 vs0, vs1; bf16x8 ks[KCH]; } sr_[SDEPTH];
#define SLOAD(i, k0) do { KOFFS(); (void)kdo; (void)vst0; (void)vst1; const char* vb_ = (const char*)(Vh + (size_t)(k0) * LDV); const char* kb_ = (const char*)(Kh + (size_t)(k0) * LDK); \
    sr_[i].vs0 = *(const bf16x8*)(vb_ + vso0); sr_[i].vs1 = *(const bf16x8*)(vb_ + vso1); \
    _Pragma("unroll") for (int c_ = 0; c_ < KCH; ++c_) sr_[i].ks[c_] = *(const bf16x8*)(kb_ + kso[c_]); } while (0)
#define SWRITE(b, i) do { KOFFS(); (void)kso; (void)vso0; (void)vso1; *(LAS bf16x8*)(V_lds + (b) * SHM_V + vst0) = sr_[i].vs0; *(LAS bf16x8*)(V_lds + (b) * SHM_V + vst1) = sr_[i].vs1; \
    _Pragma("unroll") for (int c_ = 0; c_ < KCH; ++c_) *(LAS bf16x8*)(K_lds + (b) * SHM_K + kdo[c_]) = sr_[i].ks[c_]; } while (0)
#define SWAIT() do { if constexpr (SDEPTH == 2) { if constexpr (KCH == 1) asm volatile("s_waitcnt vmcnt(3)" ::: "memory"); else asm volatile("s_waitcnt vmcnt(5)" ::: "memory"); } \
    else asm volatile("s_waitcnt vmcnt(0)" ::: "memory"); } while (0)
#define RESC(a) do { if (__any((a) < 1.f)) { if (hi == 0) al_l[r32] = (a); asm volatile("s_waitcnt lgkmcnt(0)" ::: "memory"); \
    _Pragma("unroll") for (int d = 0; d < 4; ++d) _Pragma("unroll") for (int r = 0; r < 16; ++r) o[d][r] *= al_l[crow(r, hi)]; } } while (0)
#define ABIAS(P0, P1, t) do { if (BIAS && (t) >= bias_from) { const LAS float* bp_ = btab + (bias_idx0 + 64 * (t) + 4 * hi); \
    _Pragma("unroll") for (int r = 0; r < 16; ++r) { P0[r] += bp_[(r & 3) + 8 * (r >> 2)]; P1[r] += bp_[32 + (r & 3) + 8 * (r >> 2)]; } } } while (0)
    f32x16 pA0, pA1, pB0, pB1; float mnA, mnB, alA = 1.f, alB = 1.f; bf16x8 pa0, pa1, pa2, pa3;
    static_assert(SDEPTH == 1, "ring version stages one tile in registers");
    int sp = 2, sc = 0, sn = 1;
#define ROT3() do { const int t_ = sp; sp = sc; sc = sn; sn = t_; } while (0)
    __syncthreads();
    SLOAD(0, 0); asm volatile("s_waitcnt vmcnt(0)" ::: "memory"); SWRITE(0, 0);
    SLOAD(0, KVBLK);
    __syncthreads();
    qkt<DQK>(pA0, pA1, K_lds, qr, r32, hi); ABIAS(pA0, pA1, 0); partialSM(pA0, pA1, m_reg, mnA, alA);
    SWRITE(1, 0); if (2 < NT) SLOAD(0, 2 * KVBLK);
    __syncthreads();
    ROT3();
    for (int j = 1; j + 1 < NT; j += 2) {
        const bool aj = j < NTw, ajm = (j - 1) < NTw, ajp = (j + 1) < NTw;
        if constexpr (QFIRST) {
            SBAR(); if (aj) { qkt<DQK>(pB0, pB1, K_lds + sc * SHM_K, qr, r32, hi); ABIAS(pB0, pB1, j); }
            if (ajm) finishSM(pA0, pA1, alA, l_reg, pa0, pa1, pa2, pa3); SBAR();
            if (ajm) pv_d0(o, vb0 + sp * SHM_V, pa0, pa1, pa2, pa3);
        } else {
            SBAR(); if (ajm) finishSM(pA0, pA1, alA, l_reg, pa0, pa1, pa2, pa3); SBAR();
            if (ajm) pv_d0(o, vb0 + sp * SHM_V, pa0, pa1, pa2, pa3);
            SBAR(); if (aj) { qkt<DQK>(pB0, pB1, K_lds + sc * SHM_K, qr, r32, hi); ABIAS(pB0, pB1, j); }
        }
        if (aj) partialSM(pB0, pB1, m_reg, mnB, alB); else alB = 1.f;
        SBAR(); SWRITE(sn, 0); if (j + 2 < NT) SLOAD(0, (j + 2) * KVBLK); SBAR();
        RESC(alB); __syncthreads(); ROT3();
        if constexpr (QFIRST) {
            SBAR(); if (ajp) { qkt<DQK>(pA0, pA1, K_lds + sc * SHM_K, qr, r32, hi); ABIAS(pA0, pA1, j + 1); }
            if (aj) finishSM(pB0, pB1, alB, l_reg, pa0, pa1, pa2, pa3); SBAR();
            if (aj) pv_d0(o, vb0 + sp * SHM_V, pa0, pa1, pa2, pa3);
        } else {
            SBAR(); if (aj) finishSM(pB0, pB1, alB, l_reg, pa0, pa1, pa2, pa3); SBAR();
            if (aj) pv_d0(o, vb0 + sp * SHM_V, pa0, pa1, pa2, pa3);
            SBAR(); if (ajp) { qkt<DQK>(pA0, pA1, K_lds + sc * SHM_K, qr, r32, hi); ABIAS(pA0, pA1, j + 1); }
        }
        if (ajp) partialSM(pA0, pA1, m_reg, mnA, alA); else alA = 1.f;
        SBAR(); if (j + 2 < NT) SWRITE(sn, 0); if (j + 3 < NT) SLOAD(0, (j + 3) * KVBLK); SBAR();
        RESC(alA); __syncthreads(); ROT3();
    }
    { const bool aj = (NT - 1) < NTw, ajm = (NT - 2) < NTw;
      SBAR(); if (aj) { qkt<DQK>(pB0, pB1, K_lds + sc * SHM_K, qr, r32, hi); ABIAS(pB0, pB1, NT - 1); }
      if (ajm) finishSM(pA0, pA1, alA, l_reg, pa0, pa1, pa2, pa3); SBAR();
      if (ajm) pv_d0(o, vb0 + sp * SHM_V, pa0, pa1, pa2, pa3);
      if (aj) partialSM(pB0, pB1, m_reg, mnB, alB); else alB = 1.f;
      RESC(alB);
      if (aj) { finishSM(pB0, pB1, alB, l_reg, pa0, pa1, pa2, pa3); SBAR(); pv_d0(o, vb0 + sc * SHM_V, pa0, pa1, pa2, pa3); } }
#undef ROT3
#undef SLOAD
#undef KOFFS
#undef SWRITE
#undef SWAIT
#undef RESC
#undef ABIAS
}
DI void inv_l(LAS float* wsf, float l_reg, int r32, int hi, float (&rli)[16]) {
    if (hi == 0) wsf[r32] = l_reg; asm volatile("s_waitcnt lgkmcnt(0)" ::: "memory");
#pragma unroll
    for (int r = 0; r < 16; ++r) rli[r] = __builtin_amdgcn_rcpf(wsf[crow(r, hi)]);
    asm volatile("s_waitcnt lgkmcnt(0)" ::: "memory");
}
#ifndef DIFF_SDEPTH
#define DIFF_SDEPTH 1
#endif
#ifndef MLA_SDEPTH
#define MLA_SDEPTH 1
#endif
constexpr int OSTG_ROW = 272, OSTG_WAVE = 32 * OSTG_ROW;
static_assert(NWAVES * OSTG_WAVE <= Cfg<64>::OFF_WS, "the stage overlays the V/K rings only");
DI void ostage_put(LAS char* stg, int row, int col, float v) { *(LAS bf16*)(stg + row * OSTG_ROW + col * 2) = (bf16)(pk2(v, 0.f) & 0xffffu); }
DI void ostage_flush(const LAS char* stg, bf16* Orow0, int lane) {
    asm volatile("s_waitcnt lgkmcnt(0)" ::: "memory");
#pragma unroll
    for (int i = 0; i < 8; ++i) { const int row = 4 * i + (lane >> 4), ch = lane & 15; *(v4u*)(Orow0 + (long)row * D + ch * 8) = *(const LAS v4u*)(stg + row * OSTG_ROW + ch * 16); }
}
DI void mla_unit(LAS char* lds, int b, int h, int qb, const bf16* QM, const bf16* KM, const bf16* VM, bf16* MIX) {
    const int tid = ltid(), wid = __builtin_amdgcn_readfirstlane(tid >> 6), lane = tid & 63, r32 = lane & 31, hi = lane >> 5;
    const long row0 = (long)b * SEQ + qb * 256 + wid * 32;
    const bf16* Qw = QM + (row0 + r32) * UQN + h * 192 + hi * 8;
    const bf16* Kh = KM + (long)b * SEQ * UQN + h * 192; const bf16* Vh = VM + (long)b * SEQ * 768 + h * 128;
    f32x16 o[4]; float l;
#if ATT_STAGGER & 1
    if (wid < 4) attn_pass<192, false, MLA_SDEPTH, UQN, 768, true>(lds, Qw, Kh, Vh, 4 * qb + 4, 4 * qb + (wid >> 1) + 1, 0, 0, o, l);
    else attn_pass<192, false, MLA_SDEPTH, UQN, 768, false>(lds, Qw, Kh, Vh, 4 * qb + 4, 4 * qb + (wid >> 1) + 1, 0, 0, o, l);
#else
    attn_pass<192, false, MLA_SDEPTH, UQN, 768, true>(lds, Qw, Kh, Vh, 4 * qb + 4, 4 * qb + (wid >> 1) + 1, 0, 0, o, l);
#endif
    LAS float* wsf = (LAS float*)(lds + Cfg<192>::OFF_WS) + wid * 64;
    float rli[16]; inv_l(wsf, l, r32, hi, rli);
    int r32b = r32, hib = hi, widb = wid; asm volatile("" : "+v"(r32b), "+v"(hib), "+s"(widb));
    __syncthreads();
    LAS char* stg = lds + widb * OSTG_WAVE;
#pragma unroll
    for (int r = 0; r < 16; ++r) { const int orow = (r & 3) + 8 * (r >> 2) + 4 * hib;
#pragma unroll
        for (int d0 = 0; d0 < 4; ++d0) ostage_put(stg, orow, d0 * 32 + r32b, o[d0][r] * rli[r]); }
    ostage_flush(stg, MIX + row0 * D + MX_ML + h * 128, lane);
}
DI void diff_unit(LAS char* lds, int b, int h, int qb, const bf16* QN, const bf16* KN, const bf16* PROJ, float* scr, bf16* MIX, const float* bias2, float lam, float omli, const float* subln) {
    const int tid = ltid(), wid = __builtin_amdgcn_readfirstlane(tid >> 6), lane = tid & 63, r32 = lane & 31, hi = lane >> 5;
    LAS float* btab = (LAS float*)(lds + Cfg<64>::OFF_BIAS);
    __syncthreads();
    if (tid < 256) btab[tid] = bias2[h * 256 + tid];
    const int q0 = qb * 256, X = q0 + 32 * wid - 153;
    const int bias_from = X <= 0 ? 0 : ((X + 63) >> 6), bias_idx0 = 192 - (q0 + 32 * wid + r32);
    const long row0 = (long)b * SEQ + q0 + wid * 32;
    const bf16* Vh = PROJ + (long)b * SEQ * PINP + C_DV + h * 128;
    LAS float* wsf = (LAS float*)(lds + Cfg<64>::OFF_WS) + wid * 64;
    f32x16 o[4]; float l; float rli[16];
    { const bf16* Qw = QN + (row0 + r32) * 512 + h * 128 + hi * 8; const bf16* Kh = KN + (long)b * SEQ * 512 + h * 128;
#if ATT_STAGGER & 2
      if (wid < 4) attn_pass<64, true, DIFF_SDEPTH, 512, PINP, true>(lds, Qw, Kh, Vh, 4 * qb + 4, 4 * qb + (wid >> 1) + 1, bias_from, bias_idx0, o, l);
      else attn_pass<64, true, DIFF_SDEPTH, 512, PINP, false>(lds, Qw, Kh, Vh, 4 * qb + 4, 4 * qb + (wid >> 1) + 1, bias_from, bias_idx0, o, l);
#else
      attn_pass<64, true, DIFF_SDEPTH, 512, PINP, true>(lds, Qw, Kh, Vh, 4 * qb + 4, 4 * qb + (wid >> 1) + 1, bias_from, bias_idx0, o, l);
#endif
    }
    inv_l(wsf, l, r32, hi, rli);
    int r32b = r32, hib = hi; asm volatile("" : "+v"(r32b), "+v"(hib));
    int tidb = tid; asm volatile("" : "+v"(tidb));
    f32x4* sw4 = (f32x4*)scr + tidb;
#pragma unroll
    for (int r = 0; r < 16; ++r) { sw4[r * NTHREADS] = (f32x4){o[0][r] * rli[r], o[1][r] * rli[r], o[2][r] * rli[r], o[3][r] * rli[r]};
        asm volatile("" ::: "memory"); }
    { const bf16* Qw = QN + (row0 + r32) * 512 + h * 128 + 64 + hi * 8; const bf16* Kh = KN + (long)b * SEQ * 512 + h * 128 + 64;
#if ATT_STAGGER & 2
      if (wid < 4) attn_pass<64, true, DIFF_SDEPTH, 512, PINP, true>(lds, Qw, Kh, Vh, 4 * qb + 4, 4 * qb + (wid >> 1) + 1, bias_from, bias_idx0, o, l);
      else attn_pass<64, true, DIFF_SDEPTH, 512, PINP, false>(lds, Qw, Kh, Vh, 4 * qb + 4, 4 * qb + (wid >> 1) + 1, bias_from, bias_idx0, o, l);
#else
      attn_pass<64, true, DIFF_SDEPTH, 512, PINP, true>(lds, Qw, Kh, Vh, 4 * qb + 4, 4 * qb + (wid >> 1) + 1, bias_from, bias_idx0, o, l);
#endif
    }
    inv_l(wsf, l, r32, hi, rli);
    int widb = wid; asm volatile("" : "+v"(r32b), "+v"(hib), "+v"(tidb), "+s"(widb));
    sw4 = (f32x4*)scr + tidb;
    float sg[4];
#pragma unroll
    for (int d0 = 0; d0 < 4; ++d0) sg[d0] = subln[d0 * 32 + r32b] * omli;
    f32x4 o1v[16];
#pragma unroll
    for (int r = 0; r < 16; ++r) o1v[r] = sw4[r * NTHREADS];
    __syncthreads();
    LAS char* stg = lds + widb * OSTG_WAVE;
#pragma unroll
    for (int r = 0; r < 16; ++r) { const int orow = (r & 3) + 8 * (r >> 2) + 4 * hib; float v[4]; float ss = 0.f;
#pragma unroll
        for (int d0 = 0; d0 < 4; ++d0) { v[d0] = o1v[r][d0] - lam * (o[d0][r] * rli[r]); ss += v[d0] * v[d0]; }
        ss += __shfl_xor(ss, 1); ss += __shfl_xor(ss, 2); ss += __shfl_xor(ss, 4); ss += __shfl_xor(ss, 8); ss += __shfl_xor(ss, 16);
        const float rn = frsqrt(ss * (1.0f / 128.0f) + EPS);
#pragma unroll
        for (int d0 = 0; d0 < 4; ++d0) ostage_put(stg, orow, d0 * 32 + r32b, v[d0] * rn * sg[d0]);
        asm volatile("" ::: "memory"); }
    ostage_flush(stg, MIX + row0 * D + MX_DF + h * 128, lane);
}
#undef SBAR
}

namespace hg {
constexpr int QROW = 272, PROW = 144;
DI void pre_units(LAS char* lds, int u0, int ustride, int nunits, const bf16* PROJ, const float* LF, bf16* QI, bf16* Pm, bf16* KDT, bf16* VT, float* DEC) {
    const int tid = ltid(), tg = __builtin_amdgcn_readfirstlane(tid >> 6), d2 = tid & 63, lane = d2;
    LAS char* qt = lds; LAS char* kt = lds + 64 * QROW; LAS float* tot = (LAS float*)(lds + 2 * 64 * QROW);
    f32x2 lfn[8]; unsigned qn[8], kn[8], vn[8];
#define PLOAD(unit_) do { const int h_ = (unit_) % 6; const long m0_ = (long)((unit_) / 6) * 64; \
    _Pragma("unroll") for (int i = 0; i < 8; ++i) { lfn[i] = *(const f32x2*)(LF + (m0_ + 8 * tg + i) * HGW + h_ * 128 + 2 * d2); \
        const bf16* rp_ = PROJ + (m0_ + 8 * tg + i) * PINP + h_ * 128 + 2 * d2; qn[i] = *(const unsigned*)(rp_ + C_HQ); kn[i] = *(const unsigned*)(rp_ + C_HF); vn[i] = *(const unsigned*)(rp_ + C_HI); } } while (0)
    if (u0 < nunits) PLOAD(u0);
    for (int unit = u0; unit < nunits; unit += ustride) {
    float c0[8], c1[8]; unsigned qw[8], kw[8], vw[8];
    { float a0 = 0.f, a1 = 0.f;
#pragma unroll
      for (int i = 0; i < 8; ++i) { a0 += lfn[i][0]; a1 += lfn[i][1]; c0[i] = a0; c1[i] = a1; qw[i] = qn[i]; kw[i] = kn[i]; vw[i] = vn[i]; }
      tot[tg * 128 + 2 * d2] = a0; tot[tg * 128 + 2 * d2 + 1] = a1; }
    if (unit + ustride < nunits) PLOAD(unit + ustride);
    __syncthreads();
    float pre0 = 0.f, pre1 = 0.f, ref0 = 0.f, ref1 = 0.f, last0 = 0.f, last1 = 0.f;
#pragma unroll
    for (int g = 0; g < 8; ++g) { const float t0 = tot[g * 128 + 2 * d2], t1 = tot[g * 128 + 2 * d2 + 1];
        if (g < tg) { pre0 += t0; pre1 += t1; } if (g < 4) { ref0 += t0; ref1 += t1; } last0 += t0; last1 += t1; }
    unsigned kd0[4], kd1[4], v0[4], v1[4];
    float pkd0 = 0.f, pkd1 = 0.f;
#pragma unroll
    for (int i = 0; i < 8; ++i) { const int t = 8 * tg + i; const float cu0 = pre0 + c0[i], cu1 = pre1 + c1[i];
        const float q0 = bflo(qw[i]), q1 = bfhi(qw[i]), k0 = bflo(kw[i]), k1 = bfhi(kw[i]);
        const float e10 = fexp(fminf(cu0 - ref0, 80.f)), e11 = fexp(fminf(cu1 - ref1, 80.f));
        const float e20 = fexp(fminf(ref0 - cu0, 80.f)), e21 = fexp(fminf(ref1 - cu1, 80.f));
        *(LAS unsigned*)(qt + t * QROW + d2 * 4) = pk2(q0 * e10, q1 * e11);
        *(LAS unsigned*)(kt + t * QROW + d2 * 4) = pk2(k0 * e20, k1 * e21);
        *(unsigned*)(QI + (size_t)unit * 8192 + t * 128 + 2 * d2) = pk2(q0 * fexp(cu0), q1 * fexp(cu1));
        const float kdv0 = k0 * fexp(last0 - cu0), kdv1 = k1 * fexp(last1 - cu1);
        if (i & 1) { kd0[i >> 1] = pk2(pkd0, kdv0); kd1[i >> 1] = pk2(pkd1, kdv1); } else { pkd0 = kdv0; pkd1 = kdv1; }
    }
#pragma unroll
    for (int i = 0; i < 4; ++i) { v0[i] = (vw[2 * i] & 0xffffu) | (vw[2 * i + 1] << 16); v1[i] = (vw[2 * i] >> 16) | (vw[2 * i + 1] & 0xffff0000u); }
    { bf16* kp = KDT + (size_t)unit * 8192 + (2 * d2) * 64 + 8 * tg; *(v4u*)kp = (v4u){kd0[0], kd0[1], kd0[2], kd0[3]}; *(v4u*)(kp + 64) = (v4u){kd1[0], kd1[1], kd1[2], kd1[3]};
      bf16* vp = VT + (size_t)unit * 8192 + (2 * d2) * 64 + 8 * tg; *(v4u*)vp = (v4u){v0[0], v0[1], v0[2], v0[3]}; *(v4u*)(vp + 64) = (v4u){v1[0], v1[1], v1[2], v1[3]}; }
    if (tg == 0) { *(f32x2*)(DEC + (size_t)unit * 128 + 2 * d2) = (f32x2){fexp(last0), fexp(last1)}; }
    __syncthreads();
    { const int tb = tg >> 1, ar = lane & 15, kq = lane >> 4;
#pragma unroll
      for (int sbi = 0; sbi < 2; ++sbi) { const int sb = 2 * (tg & 1) + sbi; f32x4 acc = {0.f, 0.f, 0.f, 0.f};
          if (sb <= tb) {
#pragma unroll
              for (int ks = 0; ks < 4; ++ks) { const bf16x8 a = *(const LAS bf16x8*)(qt + (16 * tb + ar) * QROW + (32 * ks + 8 * kq) * 2);
                  const bf16x8 bb = *(const LAS bf16x8*)(kt + (16 * sb + ar) * QROW + (32 * ks + 8 * kq) * 2); acc = mfma16(a, bb, acc); } }
#pragma unroll
          for (int i = 0; i < 4; ++i) { const int t = 16 * tb + 4 * kq + i, s = 16 * sb + ar; const float v = (s <= t) ? acc[i] : 0.f;
              Pm[(size_t)unit * 4096 + t * 64 + s] = (bf16)(pk2(v, 0.f) & 0xffffu); } } }
    __syncthreads();
    }
#undef PLOAD
}
constexpr int L_QI = 0, L_P = 64 * QROW, L_KD = L_P + 64 * PROW, L_VT = L_KD + 128 * PROW, L_ST = L_VT + 128 * PROW, L_DEC = L_ST + 128 * QROW, L_OG = L_DEC + 512, L_O = L_OG + 512, OROW = 528, L_END = L_O + 64 * OROW;
static_assert(L_END <= RING_BYTES, "hgrn chain LDS map");
DI void chain(LAS char* lds, int b, int h, const bf16* QI, const bf16* Pm, const bf16* KDT, const bf16* VT, const float* DEC, const bf16* PROJ, bf16* MIX, const float* ogain) {
    const int tid = ltid(), w = __builtin_amdgcn_readfirstlane(tid >> 6), lane = tid & 63, ar = lane & 15, kq = lane >> 4;
    const int nt = tid >> 3, nsg = tid & 7;
    __syncthreads();
    for (int i = tid; i < 128 * QROW / 4; i += NTHREADS) ((LAS unsigned*)(lds + L_ST))[i] = 0u;
    f32x4 S[8], ao[4];
#pragma unroll
    for (int db = 0; db < 8; ++db) S[db] = (f32x4){0.f, 0.f, 0.f, 0.f};
#pragma unroll
    for (int tb = 0; tb < 4; ++tb) ao[tb] = (f32x4){0.f, 0.f, 0.f, 0.f};
    if (tid < 128) ((LAS float*)(lds + L_OG))[tid] = ogain[tid];
    v4u rq[2][2], rp[2], rk[2][2], rv[2][2], rgc[2], rgn[2]; f32x4 rdec[2];
    rgc[0] = rgc[1] = rgn[0] = rgn[1] = (v4u){0u, 0u, 0u, 0u};
#pragma unroll
    for (int s_ = 0; s_ < 2; ++s_) rdec[s_] = (f32x4){0.f, 0.f, 0.f, 0.f};
#define HLOAD(c, s) do { const size_t un_ = (size_t)((b * 64 + (c)) * 6 + h); \
    _Pragma("unroll") for (int i_ = 0; i_ < 2; ++i_) { const int ci_ = tid + i_ * NTHREADS; rq[s][i_] = *(const v4u*)(QI + un_ * 8192 + ci_ * 8); rk[s][i_] = *(const v4u*)(KDT + un_ * 8192 + ci_ * 8); rv[s][i_] = *(const v4u*)(VT + un_ * 8192 + ci_ * 8); } \
    rp[s] = *(const v4u*)(Pm + un_ * 4096 + tid * 8); if (tid < 32) rdec[s] = *(const f32x4*)(DEC + un_ * 128 + tid * 4); } while (0)
#define GLOAD(c) do { const bf16* gp_ = PROJ + ((size_t)b * SEQ + (c) * 64 + nt) * PINP + C_HG + h * 128 + 16 * nsg; rgn[0] = *(const v4u*)gp_; rgn[1] = *(const v4u*)(gp_ + 8); } while (0)
    HLOAD(0, 0); HLOAD(1, 1);
#define CBODY(c, s) do { \
        if ((c) < 64) { \
            _Pragma("unroll") for (int i = 0; i < 2; ++i) { const int ci = tid + i * NTHREADS; \
                *(LAS v4u*)(lds + L_QI + (ci >> 4) * QROW + (ci & 15) * 16) = rq[s][i]; \
                *(LAS v4u*)(lds + L_KD + (ci >> 3) * PROW + (ci & 7) * 16) = rk[s][i]; \
                *(LAS v4u*)(lds + L_VT + (ci >> 3) * PROW + (ci & 7) * 16) = rv[s][i]; } \
            *(LAS v4u*)(lds + L_P + (tid >> 3) * PROW + (tid & 7) * 16) = rp[s]; \
            if (tid < 32) *(LAS f32x4*)(lds + L_DEC + tid * 16) = rdec[s]; } \
        if ((c) > 0) { \
            _Pragma("unroll") for (int db = 0; db < 8; ++db) { typedef unsigned u32x2 __attribute__((ext_vector_type(2))); \
                *(LAS u32x2*)(lds + L_ST + (16 * w + ar) * QROW + (16 * db + 4 * kq) * 2) = (u32x2){pk2(S[db][0], S[db][1]), pk2(S[db][2], S[db][3])}; } \
            _Pragma("unroll") for (int tb = 0; tb < 4; ++tb) \
                _Pragma("unroll") for (int i = 0; i < 4; ++i) *(LAS float*)(lds + L_O + (16 * tb + 4 * kq + i) * OROW + (16 * w + ar) * 4) = ao[tb][i]; } \
        __syncthreads();                                               \
        if ((c) + 2 < 64) HLOAD((c) + 2, s); \
        if ((c) < 64) GLOAD(c); \
        if ((c) > 0) {     \
            const long row = (long)b * SEQ + ((c) - 1) * 64 + nt; \
            f32x4 ov[4]; float ss = 0.f; \
            _Pragma("unroll") for (int q = 0; q < 4; ++q) { ov[q] = *(const LAS f32x4*)(lds + L_O + nt * OROW + (16 * nsg + 4 * q) * 4); ss += (ov[q][0] * ov[q][0] + ov[q][1] * ov[q][1]) + (ov[q][2] * ov[q][2] + ov[q][3] * ov[q][3]); } \
            ss += __shfl_xor(ss, 1); ss += __shfl_xor(ss, 2); ss += __shfl_xor(ss, 4); \
            const float rn = frsqrt(ss * (1.0f / 128.0f) + EPS); \
            const unsigned gw[8] = {rgc[0].x, rgc[0].y, rgc[0].z, rgc[0].w, rgc[1].x, rgc[1].y, rgc[1].z, rgc[1].w}; \
            unsigned ow[8]; \
            _Pragma("unroll") for (int q = 0; q < 4; ++q) { const f32x4 gq_ = *(const LAS f32x4*)(lds + L_OG + (16 * nsg + 4 * q) * 4); \
                ow[2 * q] = pk2(ov[q][0] * rn * gq_[0] * bflo(gw[2 * q]), ov[q][1] * rn * gq_[1] * bfhi(gw[2 * q])); \
                ow[2 * q + 1] = pk2(ov[q][2] * rn * gq_[2] * bflo(gw[2 * q + 1]), ov[q][3] * rn * gq_[3] * bfhi(gw[2 * q + 1])); } \
            bf16* op = MIX + row * D + MX_HG + h * 128 + 16 * nsg; \
            *(v4u*)op = (v4u){ow[0], ow[1], ow[2], ow[3]}; *(v4u*)(op + 8) = (v4u){ow[4], ow[5], ow[6], ow[7]}; } \
        if ((c) < 64) { \
            _Pragma("unroll") for (int tb = 0; tb < 4; ++tb) ao[tb] = (f32x4){0.f, 0.f, 0.f, 0.f}; \
            bf16x8 bv[2]; \
            _Pragma("unroll") for (int ks = 0; ks < 4; ++ks) { const bf16x8 bs = *(const LAS bf16x8*)(lds + L_ST + (16 * w + ar) * QROW + (32 * ks + 8 * kq) * 2); \
                _Pragma("unroll") for (int tb = 0; tb < 4; ++tb) { const bf16x8 a = *(const LAS bf16x8*)(lds + L_QI + (16 * tb + ar) * QROW + (32 * ks + 8 * kq) * 2); ao[tb] = mfma16(a, bs, ao[tb]); } __builtin_amdgcn_sched_barrier(0); } \
            _Pragma("unroll") for (int ks = 0; ks < 2; ++ks) { bv[ks] = *(const LAS bf16x8*)(lds + L_VT + (16 * w + ar) * PROW + (32 * ks + 8 * kq) * 2); \
                _Pragma("unroll") for (int tb = 0; tb < 4; ++tb) { const bf16x8 a = *(const LAS bf16x8*)(lds + L_P + (16 * tb + ar) * PROW + (32 * ks + 8 * kq) * 2); ao[tb] = mfma16(a, bv[ks], ao[tb]); } __builtin_amdgcn_sched_barrier(0); } \
            _Pragma("unroll") for (int db = 0; db < 8; ++db) { const f32x4 dc = *(const LAS f32x4*)(lds + L_DEC + (16 * db + 4 * kq) * 4); S[db] = S[db] * dc; \
                _Pragma("unroll") for (int ks = 0; ks < 2; ++ks) { const bf16x8 a = *(const LAS bf16x8*)(lds + L_KD + (16 * db + ar) * PROW + (32 * ks + 8 * kq) * 2); S[db] = mfma16(a, bv[ks], S[db]); } if (db & 1) __builtin_amdgcn_sched_barrier(0); } \
            rgc[0] = rgn[0]; rgc[1] = rgn[1]; \
        } \
        __syncthreads();                                               \
    } while (0)
    for (int c0 = 0; c0 <= 64; c0 += 2) {
        CBODY(c0, 0);
        if (c0 + 1 <= 64) CBODY(c0 + 1, 1);
    }
#undef CBODY
#undef HLOAD
#undef GLOAD
}
}

template <int NB, int KS, int ACOL>
DI void mla_gemm(LAS char* lds, const bf16* __restrict__ Wt, const bf16* __restrict__ PROJ, long m0, int tid, int lane, int ar, int kq, f32x4 (&acc)[2][NB], float (&ssq)[2]) {
    constexpr int CPT = NB / 4, SLOTB = NB * 2 * 1024, NCH = KS / 2;
    v4u sb[CPT], sa[2][2], ac[2][2];
#pragma unroll
    for (int rb = 0; rb < 2; ++rb) { ssq[rb] = 0.f;
#pragma unroll
        for (int nb = 0; nb < NB; ++nb) acc[rb][nb] = (f32x4){0.f, 0.f, 0.f, 0.f}; }
    const bf16* ap = PROJ + (m0 + ar) * PINP + ACOL + 8 * kq;
#define MLOAD(c) do { _Pragma("unroll") for (int i_ = 0; i_ < CPT; ++i_) { const int ci_ = tid + i_ * NTHREADS, blk_ = ci_ >> 6; sb[i_] = *(const v4u*)(Wt + ((size_t)(blk_ >> 1) * KS + 2 * (c) + (blk_ & 1)) * 512 + (ci_ & 63) * 8); } \
    _Pragma("unroll") for (int k_ = 0; k_ < 2; ++k_) _Pragma("unroll") for (int r_ = 0; r_ < 2; ++r_) sa[k_][r_] = *(const v4u*)(ap + (size_t)(16 * r_) * PINP + 32 * (2 * (c) + k_)); } while (0)
#define MWRITE(slot) do { _Pragma("unroll") for (int i_ = 0; i_ < CPT; ++i_) *(LAS v4u*)(lds + (slot) * SLOTB + (tid + i_ * NTHREADS) * 16) = sb[i_]; } while (0)
    __syncthreads();
    MLOAD(0); MWRITE(0);
#pragma unroll
    for (int k = 0; k < 2; ++k)
#pragma unroll
        for (int r = 0; r < 2; ++r) ac[k][r] = sa[k][r];
    __syncthreads();
    for (int c = 0; c < NCH; ++c) {
        if (c + 1 < NCH) MLOAD(c + 1);
        const LAS char* sl = lds + (c & 1) * SLOTB + lane * 16;
#pragma unroll
        for (int k = 0; k < 2; ++k) {
#pragma unroll
            for (int r = 0; r < 2; ++r) { const v4u aw = ac[k][r];
                ssq[r] += (bflo(aw.x) * bflo(aw.x) + bfhi(aw.x) * bfhi(aw.x)) + (bflo(aw.y) * bflo(aw.y) + bfhi(aw.y) * bfhi(aw.y)) + (bflo(aw.z) * bflo(aw.z) + bfhi(aw.z) * bfhi(aw.z)) + (bflo(aw.w) * bflo(aw.w) + bfhi(aw.w) * bfhi(aw.w)); }
#pragma unroll
            for (int nb = 0; nb < NB; ++nb) { const bf16x8 bb = *(const LAS bf16x8*)(sl + (nb * 2 + k) * 1024);
                acc[0][nb] = mfma16(__builtin_bit_cast(bf16x8, ac[k][0]), bb, acc[0][nb]); acc[1][nb] = mfma16(__builtin_bit_cast(bf16x8, ac[k][1]), bb, acc[1][nb]);
                if ((nb & 3) == 3) __builtin_amdgcn_sched_barrier(0); } }
        if (c + 1 < NCH) { MWRITE((c + 1) & 1);
#pragma unroll
            for (int k = 0; k < 2; ++k)
#pragma unroll
                for (int r = 0; r < 2; ++r) ac[k][r] = sa[k][r]; }
        __syncthreads();
    }
#undef MLOAD
#undef MWRITE
#pragma unroll
    for (int rb = 0; rb < 2; ++rb) { ssq[rb] += __shfl_xor(ssq[rb], 16); ssq[rb] += __shfl_xor(ssq[rb], 32); }
}
template <int NB, int KS, int ACOL>
DI void mla_gemm_deep(LAS char* lds, const bf16* __restrict__ Wt, const bf16* __restrict__ PROJ, long m0, int tid, int lane, int ar, int kq, f32x4 (&acc)[2][NB], float (&ssq)[2]) {
    constexpr int CPT = NB / 4, SLOTB = NB * 2 * 1024, NCH = KS / 2;
    static_assert(NCH % 2 == 0, "the K loop is unrolled by two chunks");
    v4u sb0[CPT], sa0[2][2], sb1[CPT], sa1[2][2], ac[2][2];
#pragma unroll
    for (int rb = 0; rb < 2; ++rb) { ssq[rb] = 0.f;
#pragma unroll
        for (int nb = 0; nb < NB; ++nb) acc[rb][nb] = (f32x4){0.f, 0.f, 0.f, 0.f}; }
    const bf16* ap = PROJ + (m0 + ar) * PINP + ACOL + 8 * kq;
#define MLOAD(c, sb, sa) do { _Pragma("unroll") for (int i_ = 0; i_ < CPT; ++i_) { const int ci_ = tid + i_ * NTHREADS, blk_ = ci_ >> 6; sb[i_] = *(const v4u*)(Wt + ((size_t)(blk_ >> 1) * KS + 2 * (c) + (blk_ & 1)) * 512 + (ci_ & 63) * 8); } \
    _Pragma("unroll") for (int k_ = 0; k_ < 2; ++k_) _Pragma("unroll") for (int r_ = 0; r_ < 2; ++r_) sa[k_][r_] = *(const v4u*)(ap + (size_t)(16 * r_) * PINP + 32 * (2 * (c) + k_)); } while (0)
#define MWRITE(slot, sb) do { _Pragma("unroll") for (int i_ = 0; i_ < CPT; ++i_) *(LAS v4u*)(lds + (slot) * SLOTB + (tid + i_ * NTHREADS) * 16) = sb[i_]; } while (0)
#define MTAKE(sa) do { _Pragma("unroll") for (int k_ = 0; k_ < 2; ++k_) _Pragma("unroll") for (int r_ = 0; r_ < 2; ++r_) ac[k_][r_] = sa[k_][r_]; } while (0)
#define MCOMP(slot) do { const LAS char* sl = lds + (slot) * SLOTB + lane * 16; \
        _Pragma("unroll") for (int k = 0; k < 2; ++k) { \
            _Pragma("unroll") for (int r = 0; r < 2; ++r) { const v4u aw = ac[k][r]; \
                ssq[r] += (bflo(aw.x) * bflo(aw.x) + bfhi(aw.x) * bfhi(aw.x)) + (bflo(aw.y) * bflo(aw.y) + bfhi(aw.y) * bfhi(aw.y)) + (bflo(aw.z) * bflo(aw.z) + bfhi(aw.z) * bfhi(aw.z)) + (bflo(aw.w) * bflo(aw.w) + bfhi(aw.w) * bfhi(aw.w)); } \
            _Pragma("unroll") for (int nb = 0; nb < NB; ++nb) { const bf16x8 bb = *(const LAS bf16x8*)(sl + (nb * 2 + k) * 1024); \
                acc[0][nb] = mfma16(__builtin_bit_cast(bf16x8, ac[k][0]), bb, acc[0][nb]); acc[1][nb] = mfma16(__builtin_bit_cast(bf16x8, ac[k][1]), bb, acc[1][nb]); \
                if ((nb & 3) == 3) __builtin_amdgcn_sched_barrier(0); } } } while (0)
    __syncthreads();
    MLOAD(0, sb0, sa0); MLOAD(1, sb1, sa1);
    MWRITE(0, sb0); MTAKE(sa0);
    __syncthreads();
    for (int c = 0; c < NCH; c += 2) {
        if (c + 2 < NCH) MLOAD(c + 2, sb0, sa0);
        MCOMP(0);
        MWRITE(1, sb1); MTAKE(sa1);
        __syncthreads();
        if (c + 3 < NCH) MLOAD(c + 3, sb1, sa1);
        MCOMP(1);
        if (c + 2 < NCH) { MWRITE(0, sb0); MTAKE(sa0); }
        __syncthreads();
    }
#undef MLOAD
#undef MWRITE
#undef MTAKE
#undef MCOMP
#pragma unroll
    for (int rb = 0; rb < 2; ++rb) { ssq[rb] += __shfl_xor(ssq[rb], 16); ssq[rb] += __shfl_xor(ssq[rb], 32); }
}
DI void wait_vm(int n) {
    switch (n) { case 0: asm volatile("s_waitcnt vmcnt(0)" ::: "memory"); break; case 3: asm volatile("s_waitcnt vmcnt(3)" ::: "memory"); break; case 4: asm volatile("s_waitcnt vmcnt(4)" ::: "memory"); break;
        case 7: asm volatile("s_waitcnt vmcnt(7)" ::: "memory"); break; case 8: asm volatile("s_waitcnt vmcnt(8)" ::: "memory"); break; case 10: asm volatile("s_waitcnt vmcnt(10)" ::: "memory"); break;
        case 11: asm volatile("s_waitcnt vmcnt(11)" ::: "memory"); break; case 12: asm volatile("s_waitcnt vmcnt(12)" ::: "memory"); break; case 14: asm volatile("s_waitcnt vmcnt(14)" ::: "memory"); break;
        case 16: asm volatile("s_waitcnt vmcnt(16)" ::: "memory"); break; default: asm volatile("s_waitcnt vmcnt(0)" ::: "memory"); break; }
}
template <int NB, int KS, int ACOL, int ASETS>
DI void mla_gemm_dma(LAS char* lds, const bf16* __restrict__ Wt, const bf16* __restrict__ PROJ, long m0, int tid, int wid, int lane, int ar, int kq, f32x4 (&acc)[2][NB], f32x4 (&ss4)[2]) {
    constexpr int SLOTB = NB * 2 * 1024, NCH = KS / 2, NFW = NB * 2 / 8, NA = 4;
    static_assert((NB * 2) % 8 == 0 && 4 * SLOTB <= RING_BYTES, "chunk loop shape");
    constexpr int AD = ASETS - 1;
    static_assert(ASETS == 2 || ASETS == 3, "A register sets");
    v4u sa[ASETS][2][2];
#pragma unroll
    for (int rb = 0; rb < 2; ++rb) { ss4[rb] = (f32x4){0.f, 0.f, 0.f, 0.f};
#pragma unroll
        for (int nb = 0; nb < NB; ++nb) acc[rb][nb] = (f32x4){0.f, 0.f, 0.f, 0.f}; }
    unsigned ap0 = (unsigned)(((m0 + ar) * PINP + ACOL + 8 * kq) * 2), ap1 = ap0 + 16u * PINP * 2u;
#define ALD1(dst, ptr, OFFS) asm volatile("global_load_dwordx4 %0, %1, %2 offset:" OFFS : "=&v"(dst) : "v"(ptr), "s"(PROJ) : "memory")
#define ALOAD_AT(c, O0, O1) do { ALD1(sa[(c) % ASETS][0][0], ap0, O0); ALD1(sa[(c) % ASETS][0][1], ap1, O0); ALD1(sa[(c) % ASETS][1][0], ap0, O1); ALD1(sa[(c) % ASETS][1][1], ap1, O1); } while (0)
#define ALOAD(c) do { if constexpr (AD == 2) ALOAD_AT(c, "256", "320"); else ALOAD_AT(c, "128", "192"); } while (0)
#define ATIE(c) asm volatile("" : "+v"(sa[(c) % ASETS][0][0]), "+v"(sa[(c) % ASETS][0][1]), "+v"(sa[(c) % ASETS][1][0]), "+v"(sa[(c) % ASETS][1][1]))
#define BDMA(c) do { _Pragma("unroll") for (int i_ = 0; i_ < NFW; ++i_) { const int blk_ = wid + 8 * i_; \
        __builtin_amdgcn_global_load_lds((const unsigned*)(Wt + ((size_t)(blk_ >> 1) * KS + 2 * (c) + (blk_ & 1)) * 512 + lane * 8), (LAS unsigned*)(lds + ((c) & 3) * SLOTB + blk_ * 1024), 16, 0, 0); } } while (0)
#define DOT2(w, accv) __builtin_amdgcn_fdot2_f32_bf16(__builtin_bit_cast(bf16x2_t, (w)), __builtin_bit_cast(bf16x2_t, (w)), (accv), false)
#define BQLD(c, f, dst) do { _Pragma("unroll") for (int q_ = 0; q_ < 4; ++q_) dst[q_] = *(const LAS bf16x8*)(lds + ((c) & 3) * SLOTB + lane * 16 + ((4 * ((f) % (NB / 4)) + q_) * 2 + (f) / (NB / 4)) * 1024); } while (0)
#define MCOMP(c) do { \
          \
        _Pragma("unroll") for (int k = 0; k < 2; ++k) _Pragma("unroll") for (int r = 0; r < 2; ++r) ss4[r] = mfma16(__builtin_bit_cast(bf16x8, sa[(c) % ASETS][k][r]), __builtin_bit_cast(bf16x8, sa[(c) % ASETS][k][r]), ss4[r]); \
        bf16x8 bq[2][4]; BQLD(c, 0, bq[0]); \
        _Pragma("unroll") for (int f = 0; f < NB / 2; ++f) { const int k = f / (NB / 4), g = f % (NB / 4); \
            if (f + 1 < NB / 2) BQLD(c, f + 1, bq[(f + 1) & 1]); \
            __builtin_amdgcn_sched_barrier(0); \
            _Pragma("unroll") for (int q_ = 0; q_ < 4; ++q_) { const int nb = 4 * g + q_; \
                acc[0][nb] = mfma16(__builtin_bit_cast(bf16x8, sa[(c) % ASETS][k][0]), bq[f & 1][q_], acc[0][nb]); acc[1][nb] = mfma16(__builtin_bit_cast(bf16x8, sa[(c) % ASETS][k][1]), bq[f & 1][q_], acc[1][nb]); } \
            __builtin_amdgcn_sched_barrier(0); } } while (0)
    __syncthreads();
    ALOAD_AT(0, "0", "64"); if constexpr (AD == 2) ALOAD_AT(1, "128", "192"); BDMA(0); BDMA(1); BDMA(2);
    asm volatile("s_waitcnt vmcnt(0)" ::: "memory"); ATIE(0); if constexpr (AD == 2) ATIE(1); __builtin_amdgcn_s_barrier();
#pragma unroll
    for (int c = 0; c < NCH; ++c) {
        if (c + AD < NCH) ALOAD(c + AD);
        if (c + 3 < NCH) BDMA(c + 3);
        __builtin_amdgcn_sched_barrier(0);
        MCOMP(c);
        __builtin_amdgcn_sched_barrier(0);
        ap0 += 128u; ap1 += 128u;
        if (c + 1 < NCH) {
            wait_vm(AD == 2 ? (c >= 1 && c + 2 < NCH ? NFW : 0) + (c + 2 < NCH ? NA : 0) + (c + 3 < NCH ? NFW : 0) : (c + 3 < NCH ? NFW : 0));
            ATIE(c + 1);
            __builtin_amdgcn_s_barrier(); }
    }
#undef ALOAD
#undef ALOAD_AT
#undef ALD1
#undef ATIE
#undef BDMA
#undef BQLD
#undef DOT2
#undef MCOMP
}
constexpr int MSTG_ROW = 400, MSTG_WAVE = 32 * MSTG_ROW;
static_assert(NWAVES * MSTG_WAVE <= RING_BYTES, "MLA output stage");
template <int CH> DI void mstage_flush(const LAS char* stg, bf16* O, int pitch, int lane) {
    asm volatile("s_waitcnt lgkmcnt(0)" ::: "memory");
#pragma unroll
    for (int t = 0; t < 32 * CH / 64; ++t) { const int idx = t * 64 + lane, row = idx / CH, ch = idx % CH; *(v4u*)(O + (long)row * pitch + ch * 8) = *(const LAS v4u*)(stg + row * MSTG_ROW + ch * 16); }
    asm volatile("s_waitcnt lgkmcnt(0)" ::: "memory");
}
DI void mla_prep_unit(LAS char* lds, int u, const bf16* PROJ, const bf16* WUQ, const bf16* WUKV, const f32x2* rope, const float* qg, const float* kg, bf16* QM, bf16* KM, bf16* VM) {
    const int tid = ltid(), wid = __builtin_amdgcn_readfirstlane(tid >> 6), lane = tid & 63, ar = lane & 15, kq = lane >> 4;
    const int rt = u / 12, kind = u % 12; const long m0 = (long)rt * 256 + 32 * wid;
#if defined(PROBE_SEL)
#define MPB(id) do { if (PROBE_SEL == (id) && (int)blockIdx.x == PROBE_WG && ltid() == 0) ((volatile LAS unsigned*)(lds - RING_OFF + MISC_OFF))[4] = (unsigned)__builtin_amdgcn_s_memrealtime(); } while (0)
#define MPE(id) do { if (PROBE_SEL == (id) && (int)blockIdx.x == PROBE_WG && ltid() == 0) ((volatile LAS unsigned*)(lds - RING_OFF + MISC_OFF))[5] += (unsigned)__builtin_amdgcn_s_memrealtime() - ((volatile LAS unsigned*)(lds - RING_OFF + MISC_OFF))[4]; } while (0)
#else
#define MPB(id) do { } while (0)
#define MPE(id) do { } while (0)
#endif
    if (kind < 6) {
        const int h = kind; f32x4 acc[2][12]; f32x4 ssq[2];
        MPB(55); mla_gemm_dma<12, 16, C_CQ, 3>(lds, WUQ + (size_t)(h * 12) * 16 * 512, PROJ, m0, tid, wid, lane, ar, kq, acc, ssq); MPE(55); MPB(56);
        int ar_ = ar, kq_ = kq; asm volatile("" : "+v"(ar_), "+v"(kq_));
        __syncthreads();
        LAS char* stg = lds + wid * MSTG_WAVE;
        float gq[12];
#pragma unroll
        for (int nb = 0; nb < 12; ++nb) gq[nb] = qg[16 * nb + ar_];
        f32x2 csv[2][4][2];
#pragma unroll
        for (int rb = 0; rb < 2; ++rb)
#pragma unroll
            for (int i = 0; i < 4; ++i)
#pragma unroll
                for (int jb = 0; jb < 2; ++jb) csv[rb][i][jb] = rope[(int)((m0 + 16 * rb + 4 * kq_ + i) & (SEQ - 1)) * 32 + 16 * jb + ar_];
#pragma unroll
        for (int rb = 0; rb < 2; ++rb)
#pragma unroll
        for (int i = 0; i < 4; ++i) { const long row = m0 + 16 * rb + 4 * kq_ + i; const float rs = frsqrt(__shfl(ssq[rb][i], 20 * kq_ + i) * (1.0f / 512.0f) + EPS);
            float v[12]; float ss = 0.f;
#pragma unroll
            for (int nb = 0; nb < 12; ++nb) { v[nb] = acc[rb][nb][i] * rs; ss += v[nb] * v[nb]; }
            ss += __shfl_xor(ss, 1); ss += __shfl_xor(ss, 2); ss += __shfl_xor(ss, 4); ss += __shfl_xor(ss, 8);
            const float rn = frsqrt(ss * (1.0f / 192.0f) + EPS);
#pragma unroll
            for (int nb = 0; nb < 12; ++nb) v[nb] = v[nb] * rn * gq[nb];
            const int pos = (int)(row & (SEQ - 1));
#pragma unroll
            for (int jb = 0; jb < 2; ++jb) { const f32x2 cs = csv[rb][i][jb]; const float x1 = v[8 + jb], x2 = v[10 + jb]; v[8 + jb] = x1 * cs[0] - x2 * cs[1]; v[10 + jb] = x2 * cs[0] + x1 * cs[1]; }
#pragma unroll
            for (int nb = 0; nb < 12; ++nb) *(LAS bf16*)(stg + (16 * rb + 4 * kq_ + i) * MSTG_ROW + (16 * nb + ar_) * 2) = (bf16)(pk2(v[nb] * SC_MQ, 0.f) & 0xffffu); }
        mstage_flush<24>(stg, QM + m0 * UQN + h * 192, UQN, lane); MPE(56);
    } else {
        const int h = kind - 6; f32x4 acc[2][16]; f32x4 ssq[2];
        MPB(55); mla_gemm_dma<16, 8, C_CKV, 2>(lds, WUKV + (size_t)(h * 16) * 8 * 512, PROJ, m0, tid, wid, lane, ar, kq, acc, ssq); MPE(55); MPB(56);
        int ar_ = ar, kq_ = kq; asm volatile("" : "+v"(ar_), "+v"(kq_));
        __syncthreads();
        LAS char* stg = lds + wid * MSTG_WAVE;
#pragma unroll
        for (int rb = 0; rb < 2; ++rb)
#pragma unroll
        for (int i = 0; i < 4; ++i) { const float rs = frsqrt(__shfl(ssq[rb][i], 20 * kq_ + i) * (1.0f / 256.0f) + EPS);
#pragma unroll
            for (int nb = 0; nb < 8; ++nb) *(LAS bf16*)(stg + (16 * rb + 4 * kq_ + i) * MSTG_ROW + (16 * nb + ar_) * 2) = (bf16)(pk2(acc[rb][8 + nb][i] * rs, 0.f) & 0xffffu); }
        mstage_flush<16>(stg, VM + m0 * 768 + h * 128, 768, lane);
        float gk[12];
#pragma unroll
        for (int nb = 0; nb < 12; ++nb) gk[nb] = kg[16 * nb + ar_];
        f32x2 csv[2][4][2]; unsigned short krv[2][4][4];
#pragma unroll
        for (int rb = 0; rb < 2; ++rb)
#pragma unroll
            for (int i = 0; i < 4; ++i) { const long row_ = m0 + 16 * rb + 4 * kq_ + i;
#pragma unroll
                for (int jb = 0; jb < 2; ++jb) csv[rb][i][jb] = rope[(int)(row_ & (SEQ - 1)) * 32 + 16 * jb + ar_];
#pragma unroll
                for (int jb = 0; jb < 4; ++jb) krv[rb][i][jb] = PROJ[row_ * PINP + C_KR + 16 * jb + ar_]; }
#pragma unroll
        for (int rb = 0; rb < 2; ++rb)
#pragma unroll
        for (int i = 0; i < 4; ++i) { const long row = m0 + 16 * rb + 4 * kq_ + i; const float rs = frsqrt(__shfl(ssq[rb][i], 20 * kq_ + i) * (1.0f / 256.0f) + EPS);
            float v[12]; float ss = 0.f;
#pragma unroll
            for (int nb = 0; nb < 8; ++nb) { v[nb] = acc[rb][nb][i] * rs; ss += v[nb] * v[nb]; }
#pragma unroll
            for (int jb = 0; jb < 4; ++jb) { v[8 + jb] = bf2f(krv[rb][i][jb]); ss += v[8 + jb] * v[8 + jb]; }
            ss += __shfl_xor(ss, 1); ss += __shfl_xor(ss, 2); ss += __shfl_xor(ss, 4); ss += __shfl_xor(ss, 8);
            const float rn = frsqrt(ss * (1.0f / 192.0f) + EPS);
#pragma unroll
            for (int nb = 0; nb < 12; ++nb) v[nb] = v[nb] * rn * gk[nb];
            const int pos = (int)(row & (SEQ - 1));
#pragma unroll
            for (int jb = 0; jb < 2; ++jb) { const f32x2 cs = csv[rb][i][jb]; const float x1 = v[8 + jb], x2 = v[10 + jb]; v[8 + jb] = x1 * cs[0] - x2 * cs[1]; v[10 + jb] = x2 * cs[0] + x1 * cs[1]; }
#pragma unroll
            for (int nb = 0; nb < 12; ++nb) *(LAS bf16*)(stg + (16 * rb + 4 * kq_ + i) * MSTG_ROW + (16 * nb + ar_) * 2) = (bf16)(pk2(v[nb], 0.f) & 0xffffu); }
        mstage_flush<24>(stg, KM + m0 * UQN + h * 192, UQN, lane); MPE(56);
    }
}
DI void diff_norm_unit(int du, const bf16* PROJ, const float* qg, const float* kg, bf16* QN, bf16* KN) {
    const int tid = ltid(), wid = __builtin_amdgcn_readfirstlane(tid >> 6), lane = tid & 63;
    float gqv[8], gkv[8];
#pragma unroll
    for (int j = 0; j < 8; ++j) { gqv[j] = qg[((8 * lane) & 63) + j] * SC_DQ; gkv[j] = kg[((8 * lane) & 63) + j]; }
    v4u w_[8][2];
#pragma unroll
    for (int i = 0; i < 8; ++i) { const long row = (long)du * 64 + wid * 8 + i;
#pragma unroll
        for (int which = 0; which < 2; ++which) w_[i][which] = *(const v4u*)(PROJ + row * PINP + (which ? C_DK : C_DQ) + 8 * lane); }
#pragma unroll
    for (int i = 0; i < 8; ++i) { const long row = (long)du * 64 + wid * 8 + i;
#pragma unroll
        for (int which = 0; which < 2; ++which) { const v4u w = w_[i][which];
            float v[8] = {bflo(w.x), bfhi(w.x), bflo(w.y), bfhi(w.y), bflo(w.z), bfhi(w.z), bflo(w.w), bfhi(w.w)}; float ss = 0.f;
#pragma unroll
            for (int j = 0; j < 8; ++j) ss += v[j] * v[j];
            ss += __shfl_xor(ss, 1); ss += __shfl_xor(ss, 2); ss += __shfl_xor(ss, 4);
            const float rn = frsqrt(ss * (1.0f / 64.0f) + EPS);
#pragma unroll
            for (int j = 0; j < 8; ++j) v[j] = v[j] * rn * (which ? gkv[j] : gqv[j]);
            *(v4u*)((which ? KN : QN) + row * 512 + 8 * lane) = (v4u){pk2(v[0], v[1]), pk2(v[2], v[3]), pk2(v[4], v[5]), pk2(v[6], v[7])}; } }
}

DI void tr_item(const float* W, int K, int N, const float* gain, bf16* WT, int dst_row0, int k0, int n0, LAS float* scr, int lane, int tiledKS = 0) {
    { const int kk0 = lane >> 3, n4 = (lane & 7) * 4;
#pragma unroll
      for (int i = 0; i < 8; ++i) { const int kk = 8 * i + kk0; f32x4 v = *(const f32x4*)(W + (size_t)(k0 + kk) * N + n0 + n4); if (gain) v = v * gain[k0 + kk];
          LAS float* d = scr + kk * 33 + n4; d[0] = v[0]; d[1] = v[1]; d[2] = v[2]; d[3] = v[3]; } }
    LDS_WAIT(); asm volatile("" ::: "memory");
    const int c = lane & 7;
#pragma unroll
    for (int j = 0; j < 4; ++j) { const int n = (lane >> 3) + 8 * j; const LAS float* s = scr + (8 * c) * 33 + n;
        v4u o; o.x = pk2(s[0 * 33], s[1 * 33]); o.y = pk2(s[2 * 33], s[3 * 33]); o.z = pk2(s[4 * 33], s[5 * 33]); o.w = pk2(s[6 * 33], s[7 * 33]);
        const int nn = dst_row0 + n, kk = k0 + 8 * c;
        const size_t off = tiledKS ? ((((size_t)(nn >> 4) * tiledKS + (kk >> 5)) * 64 + ((kk >> 3) & 3) * 16 + (nn & 15)) * 8) : ((size_t)nn * K + kk);
        *(v4u*)(WT + off) = o; }
    LDS_WAIT(); asm volatile("" ::: "memory");
}
DI int t5_bucket(int rel) {
    const int n = rel < 0 ? -rel : rel; int v;
    if (n < 8) v = n; else if (n < 12) v = 8; else if (n < 16) v = 9; else if (n < 23) v = 10; else if (n < 32) v = 11; else if (n < 46) v = 12; else if (n < 64) v = 13; else if (n < 91) v = 14; else v = 15;
    return (rel > 0 ? 16 : 0) + v;
}

#ifndef REP_HPRE
#define REP_HPRE 1
#endif
#ifndef REP_MPREP
#define REP_MPREP 1
#endif
#ifndef REP_CHAIN
#define REP_CHAIN 1
#endif
#ifndef REP_ATT
#define REP_ATT 1
#endif
#ifndef GEMM_ALIGN_UP
#define GEMM_ALIGN_UP true
#endif
#ifndef GEMM_SP2_RES
#define GEMM_SP2_RES true
#endif
#ifndef GEMM_ALIGN_RES
#define GEMM_ALIGN_RES true
#endif
#ifndef REP_FFNUP
#define REP_FFNUP 1
#endif
#ifndef REP_WIN
#define REP_WIN 1
#endif
#ifndef REP_DOWN
#define REP_DOWN 1
#endif
#ifndef REP_WOUT
#define REP_WOUT 1
#endif
#if defined(REP_EPI)
#define REP_EPI_DIV 2
#else
#define REP_EPI_DIV 1
#endif
#ifndef GROUP_SEAMS
#define GROUP_SEAMS 2
#endif
#ifndef KREV_DOWN
#define KREV_DOWN 1
#endif
#ifndef SPLITK_WIN
#define SPLITK_WIN 0
#endif
static_assert(SPLITK_WIN == 0 || SPLITK_SLABS >= 128, "SPLITK_WIN needs the slab region (SPLITK_SLABS)");
#ifndef PREP_OVERLAP
#define PREP_OVERLAP 1
#endif
#ifndef REP_PRO
#define REP_PRO 1
#endif
#ifndef REP_PREP
#define REP_PREP 1
#endif
#ifndef REP_MIX
#define REP_MIX 1
#endif
struct SameOrder : pg8::StaticOrder { __device__ bool next(int i, pg8::Unit& u) const { pg8::Unit t; if (!pg8::StaticOrder::next(i, t)) return false; return pg8::StaticOrder::next(0, u); } };
struct Args {
    const float* in[28];
    float* out; unsigned char* ws;
    int ph_lo, ph_hi;
};
enum { I_X = 0, I_FA_NORM, I_FA_G, I_FA_U, I_FA_D, I_MIX_NORM, I_WIN, I_WOUT, I_LB, I_HG_ON, I_DQN, I_DKN, I_LQ1, I_LK1, I_LQ2, I_LK2, I_SUBLN, I_RELB, I_QLN, I_WUQ, I_KVLN, I_WUKV, I_MQN, I_MKN, I_FB_NORM, I_FB_G, I_FB_U, I_FB_D };

constexpr int TR_G = (D / 64) * (F / 32), TR_DN = (F / 64) * (D / 32), TR_IN = (D / 64) * (PIN / 32), TR_OUT = (D / 64) * (D / 32), TR_UQ = (512 / 64) * (UQN / 32), TR_UKV = (256 / 64) * (UKVN / 32);
constexpr int TR_LAYER = 6 * TR_G + TR_IN + TR_OUT + TR_UQ + TR_UKV;
static_assert(TR_DN == TR_G, "item counts");


struct TrItem { const float* W; const float* gain; bf16* WT; int K, N, dst_row0, k0, n0, tiledKS; };
DI void tr_decode(const Args& A, unsigned char* ws, int it, TrItem& t) {
    const int l = it / TR_LAYER; int r = it % TR_LAYER; unsigned char* wl = ws + WS_W + (size_t)l * W_LAYER;
    t.tiledKS = 0; t.gain = nullptr;
    if (r < 6 * TR_G) { const int which = r / TR_G; r -= which * TR_G;
        const bool isb = which >= 3; const int kind = which % 3;
        if (kind < 2) { const int nblk = F / 32, kb = r / nblk, nb = r % nblk, n0 = 32 * nb;
            t.W = A.in[(isb ? I_FB_G : I_FA_G) + kind] + (size_t)l * D * F; t.gain = A.in[isb ? I_FB_NORM : I_FA_NORM] + (size_t)l * D; t.K = D; t.N = F;
            t.WT = (bf16*)(wl + (isb ? WO_GUB : WO_GUA)); t.dst_row0 = (n0 >> 7) * 256 + (n0 & 127) + kind * 128; t.k0 = 64 * kb; t.n0 = n0; }
        else { const int nblk = D / 32, kb = r / nblk, nb = r % nblk;
            t.W = A.in[isb ? I_FB_D : I_FA_D] + (size_t)l * F * D; t.K = F; t.N = D; t.WT = (bf16*)(wl + (isb ? WO_DB : WO_DA)); t.dst_row0 = 32 * nb; t.k0 = 64 * kb; t.n0 = 32 * nb; }
        return; }
    r -= 6 * TR_G;
    if (r < TR_IN) { const int nblk = PIN / 32, kb = r / nblk, nb = r % nblk;
        t.W = A.in[I_WIN] + (size_t)l * D * PIN; t.gain = A.in[I_MIX_NORM] + (size_t)l * D; t.K = D; t.N = PIN; t.WT = (bf16*)(wl + WO_IN); t.dst_row0 = 32 * nb; t.k0 = 64 * kb; t.n0 = 32 * nb; return; }
    r -= TR_IN;
    if (r < TR_OUT) { const int nblk = D / 32, kb = r / nblk, nb = r % nblk;
        t.W = A.in[I_WOUT] + (size_t)l * D * D; t.K = D; t.N = D; t.WT = (bf16*)(wl + WO_OUT); t.dst_row0 = 32 * nb; t.k0 = 64 * kb; t.n0 = 32 * nb; return; }
    r -= TR_OUT;
    if (r < TR_UQ) { const int nblk = UQN / 32, kb = r / nblk, nb = r % nblk;
        t.W = A.in[I_WUQ] + (size_t)l * 512 * UQN; t.gain = A.in[I_QLN] + (size_t)l * 512; t.K = 512; t.N = UQN; t.WT = (bf16*)(wl + WO_UQ); t.dst_row0 = 32 * nb; t.k0 = 64 * kb; t.n0 = 32 * nb; t.tiledKS = 16; return; }
    r -= TR_UQ;
    { const int nblk = UKVN / 32, kb = r / nblk, nb = r % nblk;
        t.W = A.in[I_WUKV] + (size_t)l * 256 * UKVN; t.gain = A.in[I_KVLN] + (size_t)l * 256; t.K = 256; t.N = UKVN; t.WT = (bf16*)(wl + WO_UKV); t.dst_row0 = 32 * nb; t.k0 = 64 * kb; t.n0 = 32 * nb; t.tiledKS = 8; }
}
DI void tr_load(const TrItem& t, int lane, f32x4 (&v)[8]) {
    const int kk0 = lane >> 3, n4 = (lane & 7) * 4;
#pragma unroll
    for (int i = 0; i < 8; ++i) { const int kk = 8 * i + kk0; v[i] = *(const f32x4*)(t.W + (size_t)(t.k0 + kk) * t.N + t.n0 + n4); if (t.gain) v[i] = v[i] * t.gain[t.k0 + kk]; }
}
DI void tr_store(const TrItem& t, int lane, LAS float* scr, const f32x4 (&v)[8]) {
    { const int kk0 = lane >> 3, n4 = (lane & 7) * 4;
#pragma unroll
      for (int i = 0; i < 8; ++i) { LAS float* d = scr + (8 * i + kk0) * 33 + n4; d[0] = v[i][0]; d[1] = v[i][1]; d[2] = v[i][2]; d[3] = v[i][3]; } }
    LDS_WAIT(); asm volatile("" ::: "memory");
    const int c = lane & 7;
#pragma unroll
    for (int j = 0; j < 4; ++j) { const int n = (lane >> 3) + 8 * j; const LAS float* s = scr + (8 * c) * 33 + n;
        v4u o; o.x = pk2(s[0 * 33], s[1 * 33]); o.y = pk2(s[2 * 33], s[3 * 33]); o.z = pk2(s[4 * 33], s[5 * 33]); o.w = pk2(s[6 * 33], s[7 * 33]);
        const int nn = t.dst_row0 + n, kk = t.k0 + 8 * c;
        const size_t off = t.tiledKS ? ((((size_t)(nn >> 4) * t.tiledKS + (kk >> 5)) * 64 + ((kk >> 3) & 3) * 16 + (nn & 15)) * 8) : ((size_t)nn * t.K + kk);
        *(v4u*)(t.WT + off) = o; }
    LDS_WAIT(); asm volatile("" ::: "memory");
}

#ifndef GEMM_STAGGER
#define GEMM_STAGGER 0
#endif
#ifndef SEAM_FILL
#define SEAM_FILL 2
#endif
#ifndef FFNUP_FILL
#define FFNUP_FILL 0
#endif
#ifndef MIXTAIL_CONVERT
#define MIXTAIL_CONVERT 1
#endif
constexpr int CVB = 64, CW_CVQ = 36864 + 2048;
#ifndef TAIL_CONVERT
#define TAIL_CONVERT 0
#endif
constexpr int CV_A = 5500, CV_B = 15000, CV_C = 20500;
DI void convert_range(const Args& A, unsigned char* ws, LAS unsigned char* lds, int lo, int hi, int widx, int nwg) {
    const int tid = ltid(), lane = tid & 63, wave = __builtin_amdgcn_readfirstlane(tid >> 6);
    LAS float* scr = (LAS float*)(lds + wave * 16384);
    const int NGW = nwg * NWAVES;
    TrItem cur, nxt; f32x4 va[8], vb[8];
    int it = lo + widx * NWAVES + wave; bool have = it < hi;
    if (have) { tr_decode(A, ws, it, cur); tr_load(cur, lane, va); }
    while (have) {
        const int itn = it + NGW; const bool haven = itn < hi;
        if (haven) { tr_decode(A, ws, itn, nxt); tr_load(nxt, lane, vb); }
        tr_store(cur, lane, scr, va);
        cur = nxt; it = itn; have = haven;
#pragma unroll
        for (int i = 0; i < 8; ++i) va[i] = vb[i];
    }
}

DI void prologue(const Args& A, LAS unsigned char* lds, int G) {
    const int tid = ltid(), lane = tid & 63, wave = __builtin_amdgcn_readfirstlane(tid >> 6);
    unsigned char* ws = A.ws;
    LAS float* scr = (LAS float*)(lds + wave * 16384);
    const int gw = blockIdx.x * NWAVES + wave, NGW = G * NWAVES;
    convert_range(A, ws, (LAS unsigned char*)lds, 0, TR_LAYER, (int)blockIdx.x, G);
    if (!MIXTAIL_CONVERT) for (int l = 1; l < NL; ++l) convert_range(A, ws, (LAS unsigned char*)lds, l * TR_LAYER + ((TAIL_CONVERT && G == 256) ? CV_C : 0), (l + 1) * TR_LAYER, (int)blockIdx.x, G);
    { const int gt = blockIdx.x * NTHREADS + tid, NGT = G * NTHREADS; constexpr int PER = (PINP - PIN) * D / 8;
      for (int i = gt; i < NL * PER; i += NGT) { const int l = i / PER, r = i % PER; *(v4u*)(ws + WS_W + (size_t)l * W_LAYER + WO_IN + (size_t)PIN * D * 2 + (size_t)r * 16) = (v4u){0u, 0u, 0u, 0u}; }
      float* LB = (float*)(ws + WS_CONST + CO_LB); float* LAM = (float*)(ws + WS_CONST + CO_LAM); float* BIAS = (float*)(ws + WS_CONST + CO_BIAS); f32x2* ROPE = (f32x2*)(ws + WS_CONST + CO_ROPE);
      for (int c = gt; c < HGW; c += NGT) { const float* lg = A.in[I_LB]; const float a0 = lg[c], a1 = lg[HGW + c], a2 = lg[2 * HGW + c], a3 = lg[3 * HGW + c];
          const float mx = fmaxf(fmaxf(a0, a1), fmaxf(a2, a3)); const float e0 = expf(a0 - mx), e1 = expf(a1 - mx), e2 = expf(a2 - mx), e3 = expf(a3 - mx); const float inv = 1.0f / (e0 + e1 + e2 + e3);
          const float p0 = e0 * inv, p1 = e1 * inv, p2 = e2 * inv, p3 = e3 * inv; const float c0 = p0, c1 = c0 + p1, c2 = c1 + p2, c3 = c2 + p3;
          LB[c] = c0 - c0; LB[HGW + c] = c1 - c0; LB[2 * HGW + c] = c2 - c0; LB[3 * HGW + c] = c3 - c0; }
      if (gt < NL) { const int l = gt; float s1 = 0.f, s2 = 0.f;
          for (int j = 0; j < 64; ++j) { s1 += A.in[I_LQ1][l * 64 + j] * A.in[I_LK1][l * 64 + j]; s2 += A.in[I_LQ2][l * 64 + j] * A.in[I_LK2][l * 64 + j]; }
          LAM[l] = expf(s1) - expf(s2) + (0.8f - 0.6f * expf(-0.3f * (float)l)); }
      for (int i = gt; i < 4 * 256; i += NGT) { const int h = i >> 8, rel = (i & 255) - 192; const float* rb = A.in[I_RELB];
          BIAS[i] = (rb[t5_bucket(rel) * 4 + h] - rb[15 * 4 + h]) * LOG2E; }
      for (int i = gt; i < SEQ * 32; i += NGT) { const int pos = i >> 5, j = i & 31; const float freq = exp2f(-(float)j * (13.287712379549449f / 32.0f)); const float ang = (float)pos * freq;
          double rev = (double)ang * 0.15915494309189535; rev -= floor(rev); const float rf = (float)rev;
          ROPE[i] = (f32x2){__builtin_amdgcn_cosf(rf), __builtin_amdgcn_sinf(rf)}; }
    }
    { bf16* XB = (bf16*)(ws + WS_XB); bf16* XL = (bf16*)(ws + WS_XL); float* ST = (float*)(ws + WS_STATS);
      for (int m = gw; m < M; m += NGW) { const f32x4* xr = (const f32x4*)(A.in[I_X] + (size_t)m * D) + lane; float s = 0.f;
          typedef unsigned u32x2 __attribute__((ext_vector_type(2)));
#pragma unroll
          for (int j = 0; j < 8; ++j) { const f32x4 v = xr[64 * j]; s += (v[0] * v[0] + v[1] * v[1]) + (v[2] * v[2] + v[3] * v[3]);
              const unsigned h0 = pk2(v[0], v[1]), h1 = pk2(v[2], v[3]);
              *((u32x2*)(XB + (size_t)m * D) + lane + 64 * j) = (u32x2){h0, h1};
              if (RESID_LO) *((u32x2*)(XL + (size_t)m * D) + lane + 64 * j) = (u32x2){pk2(v[0] - bflo(h0), v[1] - bfhi(h0)), pk2(v[2] - bflo(h1), v[3] - bfhi(h1))}; }
          s = wave_sum(s); if (lane < 32) ST[(size_t)m * 32 + lane] = lane == 0 ? s : 0.f; } }
}

constexpr int CW_GRP = 32768;
DI void group_barrier(gu32* ctl, int grp, unsigned& epoch, bool local) {
    asm volatile("s_waitcnt vmcnt(0)" ::: "memory");
    __syncthreads();
    ++epoch;
    if (threadIdx.x == 0) {
        unsigned* cnt = (unsigned*)(ctl + CW_GRP + 64 * grp);
        if (!local) { __builtin_amdgcn_fence(__ATOMIC_RELEASE, "agent");
        asm volatile("s_waitcnt vmcnt(0)" ::: "memory"); }
        __hip_atomic_fetch_add(cnt, 1u, __ATOMIC_RELAXED, __HIP_MEMORY_SCOPE_AGENT);
        const unsigned target = 4u * epoch; unsigned sp_ = 0;
        while (__hip_atomic_load(cnt, __ATOMIC_RELAXED, __HIP_MEMORY_SCOPE_AGENT) < target) { __builtin_amdgcn_s_sleep(1);
            if ((++sp_ & 255u) == 0u) { if (__hip_atomic_load((unsigned*)(ctl + CW_BAR) + XB_TMO, __ATOMIC_RELAXED, __HIP_MEMORY_SCOPE_AGENT)) break;
                if (sp_ > XB_SPIN_CAP) { atomicAdd((unsigned*)(ctl + CW_BAR) + XB_TMO, 1u); break; } } }
        __builtin_amdgcn_fence(__ATOMIC_ACQUIRE, "agent");
        asm volatile("s_waitcnt vmcnt(0)" ::: "memory");
    }
    __syncthreads();
}

DI void group_barrier_fill(gu32* ctl, int grp, unsigned& epoch, volatile LAS unsigned* MISC, const Args& args, unsigned char* ws, LAS unsigned char* lds, gu32* qhead, int item0) {
    asm volatile("s_waitcnt vmcnt(0)" ::: "memory");
    __syncthreads();
    ++epoch;
    gu32* cnt = ctl + CW_GRP + 64 * grp; const unsigned target = 4u * epoch;
    if (threadIdx.x == 0) __hip_atomic_fetch_add(cnt, 1u, __ATOMIC_RELAXED, __HIP_MEMORY_SCOPE_AGENT);
    for (;;) {
        __syncthreads();
        if (threadIdx.x == 0) { unsigned q = 0xffffffffu; if (__hip_atomic_load(cnt, __ATOMIC_RELAXED, __HIP_MEMORY_SCOPE_AGENT) < target) q = __hip_atomic_fetch_add(qhead, 1u, __ATOMIC_RELAXED, __HIP_MEMORY_SCOPE_AGENT); MISC[0] = q; }
        __syncthreads();
        const unsigned q = MISC[0];
        if (q == 0xffffffffu || (int)q * CVB >= TR_LAYER) break;
        const int b0 = (int)q * CVB; convert_range(args, ws, lds, item0 + b0, item0 + (b0 + CVB < TR_LAYER ? b0 + CVB : TR_LAYER), 0, 1);
    }
    if (threadIdx.x == 0) { unsigned sp_ = 0;
        while (__hip_atomic_load(cnt, __ATOMIC_RELAXED, __HIP_MEMORY_SCOPE_AGENT) < target) { __builtin_amdgcn_s_sleep(1);
            if ((++sp_ & 255u) == 0u) { if (__hip_atomic_load(ctl + CW_BAR + XB_TMO, __ATOMIC_RELAXED, __HIP_MEMORY_SCOPE_AGENT)) break;
                if (sp_ > XB_SPIN_CAP) { __hip_atomic_fetch_add(ctl + CW_BAR + XB_TMO, 1u, __ATOMIC_RELAXED, __HIP_MEMORY_SCOPE_AGENT); break; } } }
        __builtin_amdgcn_fence(__ATOMIC_ACQUIRE, "agent");
        asm volatile("s_waitcnt vmcnt(0)" ::: "memory"); }
    __syncthreads();
}

DI void xcd_barrier_fill(const XcdBarrier& b, volatile LAS unsigned* MISC, const Args& args, unsigned char* ws, LAS unsigned char* lds, gu32* ctl, int lq, bool fill) {
    asm volatile("s_waitcnt vmcnt(0)" ::: "memory");
    __syncthreads();
    if (threadIdx.x == 0) {
        unsigned* bar = b.bar;
        __builtin_amdgcn_s_waitcnt(0);
        const unsigned nloc = b.st[0], nx = b.st[1];
        const unsigned old = xb_add(&bar[XB_XSUB(b.x)], 1u);
        const unsigned gen = old / nloc;
        if (old + 1u == (gen + 1u) * nloc) {
            __builtin_amdgcn_fence(__ATOMIC_RELEASE, "agent");
            asm volatile("s_waitcnt vmcnt(0)" ::: "memory");
            const unsigned og = xb_add(&bar[XB_TOP], 1u);
            const unsigned tg = og / nx;
            if (og + 1u == (tg + 1u) * nx) xb_add(&bar[XB_TOPGEN], 1u);
            else XB_SPIN(xb_ld(&bar[XB_TOPGEN]) == tg, bar);
            __builtin_amdgcn_fence(__ATOMIC_ACQUIRE, "agent");
            xb_add(&bar[XB_XGEN(b.x)], 1u);
            asm volatile("s_waitcnt vmcnt(0)" ::: "memory");
            MISC[6] = 0u;
        } else { MISC[6] = 1u; MISC[7] = gen; }
    }
    __syncthreads();
    if (MISC[6] == 1u) {
        const unsigned gen = MISC[7];
        bool more = fill && lq + 1 < NL;
        for (;;) {
            __syncthreads();
            if (threadIdx.x == 0) { unsigned v = 0xfffffffeu;
                if (xb_ld(&b.bar[XB_XGEN(b.x)]) != gen) v = 0xffffffffu;
                else if (more) v = __hip_atomic_fetch_add(ctl + CW_CVQ + 16 * lq, 1u, __ATOMIC_RELAXED, __HIP_MEMORY_SCOPE_AGENT);
                else { XB_SPIN(xb_ld(&b.bar[XB_XGEN(b.x)]) == gen, b.bar); v = 0xffffffffu; }
                MISC[0] = v; }
            __syncthreads();
            const unsigned v = MISC[0];
            if (v == 0xffffffffu) break;
            if ((int)v * CVB >= TR_LAYER) { ++lq; more = lq + 1 < NL; continue; }
            const int b0 = (int)v * CVB, item0 = (lq + 1) * TR_LAYER; convert_range(args, ws, lds, item0 + b0, item0 + (b0 + CVB < TR_LAYER ? b0 + CVB : TR_LAYER), 0, 1);
        }
        if (threadIdx.x == 0) { __builtin_amdgcn_fence(__ATOMIC_ACQUIRE, "agent"); asm volatile("s_waitcnt vmcnt(0)" ::: "memory"); }
        __syncthreads();
    }
}

constexpr int CW_WIN = 40960;
constexpr int CW_MQ = 45056;
struct WinOrder {
    pg8::StaticOrder base; bool grp; gu32* cnt; mutable int ndone;
    __device__ __forceinline__ bool next(int i, pg8::Unit& u) const { const bool r = base.next(i, u);
        if (r && grp) { if (u.pn == 16 || u.pn == 17) u.pn += 4; else if (u.pn == 20 || u.pn == 21) u.pn -= 4; } return r; }
    __device__ __forceinline__ void a_ready(const pg8::Unit&) const {}
    __device__ __forceinline__ void done(const pg8::Unit&) const {
        if (grp && ++ndone == 5) { asm volatile("s_waitcnt vmcnt(0)" ::: "memory"); __builtin_amdgcn_s_barrier();
            if (threadIdx.x == 0) __hip_atomic_fetch_add(cnt, 1u, __ATOMIC_RELAXED, __HIP_MEMORY_SCOPE_AGENT); } }
};
__global__ void __launch_bounds__(NTHREADS, 2) fwd_kernel(Args args) {
    extern __shared__ __attribute__((aligned(16))) unsigned char lds_raw[];
    LAS unsigned char* lds0 = (LAS unsigned char*)lds_raw; LAS unsigned char* lds = lds0 + RING_OFF;
    volatile LAS unsigned* MISC = (volatile LAS unsigned*)(lds0 + MISC_OFF);
    const int tid = threadIdx.x, G = gridDim.x;
    gu32* ctl = (gu32*)(args.ws + WS_CTL);
    for (int u = tid; u < RING_OFF / 4; u += NTHREADS) ((LAS unsigned*)(lds0 + LDSCTL_OFF))[u] = 0u;
    __syncthreads();
    XcdBarrier bar = xcd_barrier_post((unsigned*)(ctl + CW_BAR), MISC + 8);
    const int lo = args.ph_lo, hi = args.ph_hi;
    int ph = 0;
#define IN(k) (lo <= (k) && (k) < hi)
#if defined(PROBE_SEL)
#define PM_B(id) do { if (PROBE_SEL == (id) && (int)blockIdx.x == PROBE_WG && tid == 0) MISC[4] = (unsigned)__builtin_amdgcn_s_memrealtime(); } while (0)
#define PM_E(id) do { if (PROBE_SEL == (id) && (int)blockIdx.x == PROBE_WG && tid == 0) MISC[5] += (unsigned)__builtin_amdgcn_s_memrealtime() - MISC[4]; } while (0)
#else
#define PM_B(id) do { } while (0)
#define PM_E(id) do { } while (0)
#endif
#define SEAM(k) do { if (IN(k) && IN((k) + 1)) { PM_B(1); PM_B(11); xcd_barrier(bar); PM_E(1); PM_E(11); } } while (0)
    unsigned gepoch = 0; const int grp = (int)blockIdx.x & 63;
    int gmode = 0;
    if (GROUP_SEAMS == 2 && tid == 0) __hip_atomic_store(ctl + CW_XCC + blockIdx.x, xb_xcc_id() + 1u, __ATOMIC_RELAXED, __HIP_MEMORY_SCOPE_AGENT);
#define GSEAM(k) do { if (IN(k) && IN((k) + 1)) { PM_B(1); PM_B(12); \
        if (GROUP_SEAMS == 1 && G == 256) group_barrier(ctl, grp, gepoch, false); \
        else if (GROUP_SEAMS == 2 && gmode == 1) group_barrier(ctl, grp, gepoch, true); \
        else { xcd_barrier(bar); \
            if (GROUP_SEAMS == 2 && gmode == 0) { if (tid == 0) MISC[1] = __hip_atomic_load(ctl + CW_NONLOCAL, __ATOMIC_RELAXED, __HIP_MEMORY_SCOPE_AGENT); __syncthreads(); gmode = (MISC[1] == 0u && G == 256) ? 1 : 2; } } PM_E(1); PM_E(12); } } while (0)

#define STAGGER_IN() do { if (GEMM_STAGGER > 0 && gmode == 1) { const unsigned long long t_end_ = __builtin_amdgcn_s_memrealtime() + (unsigned long long)((unsigned)grp * (unsigned)(GEMM_STAGGER * 100) / 64u); \
        while (__builtin_amdgcn_s_memrealtime() < t_end_) __builtin_amdgcn_s_sleep(2); } } while (0)
#define WS_PTRS() const unsigned long long ws_u_ = (unsigned long long)args.ws; unsigned char* ws = (unsigned char*)(GAS unsigned char*)ws_u_; \
    bf16* XB = (bf16*)(ws + WS_XB); bf16* XL = (bf16*)(ws + WS_XL); float* STATS = (float*)(ws + WS_STATS); bf16* HB = (bf16*)(ws + WS_A); bf16* PROJ = (bf16*)(ws + WS_A); float* LF = (float*)(ws + WS_LF); \
    bf16* QI = (bf16*)(ws + WS_QI); bf16* PM = (bf16*)(ws + WS_P); bf16* KDT = (bf16*)(ws + WS_KDT); bf16* VT = (bf16*)(ws + WS_VT); float* DEC = (float*)(ws + WS_DEC); \
    bf16* QM = (bf16*)(ws + WS_QM); bf16* KM = (bf16*)(ws + WS_KM); bf16* VM = (bf16*)(ws + WS_VM); bf16* QN = (bf16*)(ws + WS_QN); bf16* KN = (bf16*)(ws + WS_KN); \
    float* SCR = (float*)(ws + WS_SCR); bf16* MIX = (bf16*)(ws + WS_MIX); \
    const float* LB = (const float*)(ws + WS_CONST + CO_LB); const float* LAM = (const float*)(ws + WS_CONST + CO_LAM); const float* BIAS = (const float*)(ws + WS_CONST + CO_BIAS); const f32x2* ROPE = (const f32x2*)(ws + WS_CONST + CO_ROPE); \
    unsigned char* wl = ws + WS_W + (size_t)l * W_LAYER; \
    (void)XB; (void)XL; (void)STATS; (void)HB; (void)PROJ; (void)LF; (void)QI; (void)PM; (void)KDT; (void)VT; (void)DEC; (void)QM; (void)KM; (void)VM; (void)QN; (void)KN; (void)SCR; (void)MIX; (void)LB; (void)LAM; (void)BIAS; (void)ROPE; (void)wl

#ifndef NO_PRO
    PM_B(8); if (IN(ph)) { for (int rep_ = 0; rep_ < REP_PRO; ++rep_) prologue(args, lds, G); } PM_E(8);
#endif
    PM_B(16); SEAM(ph); PM_E(16); ++ph;
    if (GROUP_SEAMS == 2 && tid == 0 && lo == 0 && hi > 1) {
        bool same = G == 256;
#if defined(FORCE_NONLOCAL)
        same = false;
#endif
        if (same) { const unsigned x0 = __hip_atomic_load(ctl + CW_XCC + grp, __ATOMIC_RELAXED, __HIP_MEMORY_SCOPE_AGENT);
            for (int j = 1; j < 4; ++j) same = same && (__hip_atomic_load(ctl + CW_XCC + grp + 64 * j, __ATOMIC_RELAXED, __HIP_MEMORY_SCOPE_AGENT) == x0) && x0 != 0u; }
        if (!same) __hip_atomic_fetch_or(ctl + CW_NONLOCAL, 1u, __ATOMIC_RELAXED, __HIP_MEMORY_SCOPE_AGENT); }

    for (int s = 0; s < 3 * NL; ++s) {
        const int l = s / 3, kind = s % 3;
        if (kind != 1) {
#ifndef NO_FFN1
            PM_B(2); if (IN(ph)) for (int rf_ = 0; rf_ < REP_FFNUP; ++rf_) { WS_PTRS(); const bf16* Wgu = (const bf16*)(wl + (kind == 0 ? WO_GUA : WO_GUB)); pg8::Gemm g{XB, Wgu, M, NGU, D}; pg8::StaticOrder S; S.init(M, NGU, G, (int)blockIdx.x); EpiSwiGLU E{HB, STATS, {}, -1};
#if defined(PROBE_SAMEUNIT)
                if (rf_ == 1) { SameOrder S2; S2.init(M, NGU, G, (int)blockIdx.x); pg8::gemm_phase<EpiSwiGLU, SameOrder, GEMM_ALIGN_UP, true>(lds, g, S2, E); } else
#endif
                pg8::gemm_phase<EpiSwiGLU, pg8::StaticOrder, GEMM_ALIGN_UP, true>(lds, g, S, E);
                if (TAIL_CONVERT && l + 1 < NL && G == 256 && (int)blockIdx.x >= 192) { const int base = (l + 1) * TR_LAYER; convert_range(args, ws, lds, base + (kind == 0 ? 0 : CV_B), base + (kind == 0 ? CV_A : CV_C), (int)blockIdx.x - 192, 64); } }
#endif
            PM_E(2);
            if (FFNUP_FILL && MIXTAIL_CONVERT && GROUP_SEAMS == 2 && gmode == 1 && l + 1 < NL && ((int)blockIdx.x >> 6) == 3 && IN(ph) && IN(ph + 1))
                group_barrier_fill(ctl, grp, gepoch, MISC, args, args.ws, lds, ctl + CW_CVQ + 16 * l, (l + 1) * TR_LAYER);
            else GSEAM(ph);
            ++ph;
#ifndef NO_FFN2
            PM_B(3); if (IN(ph)) { WS_PTRS(); const bf16* Wdn = (const bf16*)(wl + (kind == 0 ? WO_DA : WO_DB)); pg8::Gemm g{HB, Wdn, M, D, F, HP}; pg8::StaticOrder S; S.init(M, D, G, (int)blockIdx.x); EpiResid E{args.out, XB, XL, STATS, 0.5f, s == 3 * NL - 1};
                pg8::gemm_phase<EpiResid, pg8::StaticOrder, GEMM_ALIGN_RES, GEMM_SP2_RES, KREV_DOWN>(lds, g, S, E); }
#endif
            PM_E(3); GSEAM(ph); ++ph;
        } else {
#ifndef NO_WIN
            PM_B(4); if (IN(ph)) for (int rw_ = 0; rw_ < REP_WIN; ++rw_) { WS_PTRS(); pg8::Gemm g{XB, (const bf16*)(wl + WO_IN), M, PINP, D}; EpiProj E{PROJ, LF, STATS, LB + l * HGW, {}, -1};
#if SPLITK_WIN
                typedef pg8::SplitOrder<PINP / 256, D / 64, SPLITK_WIN, 2, 2> WinOrder;
                { WinOrder S{(int)blockIdx.x, ws + WS_SLAB, ctl + CW_SPL + (l + 12 * rw_) * 192 * 16, ctl + CW_BAR + XB_TMO}; pg8::gemm_phase<EpiProj, WinOrder, true, true, 0, 1>(lds, g, S, E); }
#else
                { WinOrder S; S.base.init(M, PINP, G, (int)blockIdx.x); S.grp = PREP_OVERLAP && gmode == 1 && IN(ph + 1); S.cnt = ctl + CW_WIN + (l * 64 + grp) * 16; S.ndone = 0;
                STAGGER_IN(); pg8::gemm_phase<EpiProj, WinOrder, true, true>(lds, g, S, E); }
#endif
                if (TAIL_CONVERT && l + 1 < NL && G == 256 && (int)blockIdx.x >= 128) { const int base = (l + 1) * TR_LAYER; convert_range(args, ws, lds, base + CV_A, base + CV_B, (int)blockIdx.x - 128, 128); } }
#endif
            PM_E(4);
            const bool pgrp = PREP_OVERLAP && gmode == 1 && IN(ph) && IN(ph + 1);
            if (pgrp) { PM_B(1); PM_B(13); if (tid == 0) { gu32* cnt = ctl + CW_WIN + (l * 64 + grp) * 16; unsigned sp_ = 0;
                    while (__hip_atomic_load(cnt, __ATOMIC_RELAXED, __HIP_MEMORY_SCOPE_AGENT) < 4u) { __builtin_amdgcn_s_sleep(1);
                        if ((++sp_ & 255u) == 0u) { if (__hip_atomic_load(ctl + CW_BAR + XB_TMO, __ATOMIC_RELAXED, __HIP_MEMORY_SCOPE_AGENT)) break;
                            if (sp_ > XB_SPIN_CAP) { __hip_atomic_fetch_add(ctl + CW_BAR + XB_TMO, 1u, __ATOMIC_RELAXED, __HIP_MEMORY_SCOPE_AGENT); break; } } }
                    __builtin_amdgcn_fence(__ATOMIC_ACQUIRE, "agent"); asm volatile("s_waitcnt vmcnt(0)" ::: "memory"); }
                __syncthreads(); PM_E(1); PM_E(13); }
            else SEAM(ph);
            ++ph;
            PM_B(5); if (IN(ph)) { WS_PTRS();
                const int pm_ = 8 * ((int)blockIdx.x & 7) + (((int)blockIdx.x >> 3) & 7), j_ = (int)blockIdx.x >> 6;
#ifndef NO_HPRE
                PM_B(51); { const int u0 = pgrp ? (4 * pm_ + j_) * 6 : (int)blockIdx.x; hg::pre_units((LAS char*)lds, u0, pgrp ? 1 : G, pgrp ? u0 + 6 : 1536, PROJ, LF, QI, PM, KDT, VT, DEC); } PM_E(51);
#endif
#ifndef NO_DNORM
                PM_B(52); { const int d0 = pgrp ? 4 * pm_ + j_ : (int)blockIdx.x, d1 = pgrp ? d0 + 1 : 256; for (int u = d0; u < d1; u += G) diff_norm_unit(u, PROJ, args.in[I_DQN] + l * 64, args.in[I_DKN] + l * 64, QN, KN); } PM_E(52);
#endif
#ifndef NO_MPREP
                PM_B(53);
                for (int k_ = 0;; ++k_) { int u;
                    if (pgrp) { __syncthreads();
                        if (tid == 0) MISC[0] = __hip_atomic_fetch_add(ctl + CW_MQ + (l * 64 + grp) * 16, 1u, __ATOMIC_RELAXED, __HIP_MEMORY_SCOPE_AGENT);
                        __syncthreads();
                        const int q = (int)MISC[0]; if (q >= 12) break; u = pm_ * 12 + q; }
                    else { u = (int)blockIdx.x + k_ * G; if (u >= 768) break; }
#if defined(PROBE_SEL)
                    if (PROBE_SEL == 54 && (int)blockIdx.x == PROBE_WG && tid == 0) MISC[5] += 1000u;
#endif
                    mla_prep_unit((LAS char*)lds, u, PROJ, (const bf16*)(wl + WO_UQ), (const bf16*)(wl + WO_UKV), ROPE, args.in[I_MQN] + l * 192, args.in[I_MKN] + l * 192, QM, KM, VM); }
                PM_E(53);
#endif
            }
            PM_E(5); PM_B(14);
            if (SEAM_FILL && MIXTAIL_CONVERT && IN(ph) && IN(ph + 1) && l + 1 < NL && G > 24) { PM_B(1); xcd_barrier_fill(bar, MISC, args, args.ws, lds, ctl, l, (int)blockIdx.x >= 24); PM_E(1); }
            else SEAM(ph);
            PM_E(14); ++ph;
            PM_B(6); if (IN(ph)) for (int rep_ = 0; rep_ < REP_MIX; ++rep_) { WS_PTRS();
#ifndef NO_CHAIN
                if (blockIdx.x < 24) for (int rc_ = 0; rc_ < REP_CHAIN; ++rc_) hg::chain((LAS char*)lds, blockIdx.x / 6, blockIdx.x % 6, QI, PM, KDT, VT, DEC, PROJ, MIX, args.in[I_HG_ON] + l * 128);
#endif
                const float lam = LAM[l], omli = 1.0f - (0.8f - 0.6f * expf(-0.3f * (float)l));
                { bool att_left = true, cv_left = MIXTAIL_CONVERT && l + 1 < NL && rep_ == 0;
                  for (;;) {
                    __syncthreads();
                    if (tid == 0) { MISC[0] = att_left ? __hip_atomic_fetch_add((unsigned*)(ctl + CW_Q + 64 * (l + 4 * rep_)), 1u, __ATOMIC_RELAXED, __HIP_MEMORY_SCOPE_AGENT) : 640u;
                        MISC[2] = (cv_left && (MIXTAIL_CONVERT == 2 || !att_left)) ? __hip_atomic_fetch_add(ctl + CW_CVQ + 16 * l, 1u, __ATOMIC_RELAXED, __HIP_MEMORY_SCOPE_AGENT) : 0xffffffffu; }
                    __syncthreads();
                    const int u = (int)MISC[0]; const unsigned bq = MISC[2];
                    att_left = u < 640;
                    const bool cv_now = bq != 0xffffffffu && (int)bq * CVB < TR_LAYER;
                    if (bq != 0xffffffffu && !cv_now) cv_left = false;
                    if (!att_left && !cv_left) break;
                    if (att_left) { const int qb = 15 - u / 40, r = u % 40;
#ifndef NO_DIFF
                        if (r < 16) att::diff_unit((LAS char*)lds, r >> 2, r & 3, qb, QN, KN, PROJ, SCR + (size_t)blockIdx.x * 256 * 128, MIX, BIAS, lam, omli, args.in[I_SUBLN] + l * 128);
#endif
#ifndef NO_MLA
                        if (r >= 16) att::mla_unit((LAS char*)lds, (r - 16) / 6, (r - 16) % 6, qb, QM, KM, VM, MIX);
#endif
                    }
                    if (cv_now) { const int b0 = (int)bq * CVB; const int lo_ = (l + 1) * TR_LAYER + b0, hi_ = (l + 1) * TR_LAYER + (b0 + CVB < TR_LAYER ? b0 + CVB : TR_LAYER);
                        __syncthreads();
                        convert_range(args, ws, lds, lo_, hi_, 0, 1); }
                  } }
            }
            PM_E(6); PM_B(15);
            if (SEAM_FILL >= 2 && MIXTAIL_CONVERT && IN(ph) && IN(ph + 1) && l + 2 < NL) { PM_B(1); xcd_barrier_fill(bar, MISC, args, args.ws, lds, ctl, l + 1, true); PM_E(1); }
            else SEAM(ph);
            PM_E(15); ++ph;
#ifndef NO_WOUT
            PM_B(7); if (IN(ph)) { WS_PTRS(); pg8::Gemm g{MIX, (const bf16*)(wl + WO_OUT), M, D, D}; pg8::StaticOrder S; S.init(M, D, G, (int)blockIdx.x); EpiResid E{args.out, XB, XL, STATS, 1.0f, false};
                STAGGER_IN(); pg8::gemm_phase<EpiResid, pg8::StaticOrder, GEMM_ALIGN_RES, GEMM_SP2_RES>(lds, g, S, E); }
#endif
            PM_E(7); GSEAM(ph); ++ph;
        }
    }
#if defined(PROBE_SEL)
    if ((int)blockIdx.x == PROBE_WG && tid == 0) { const unsigned long long t_end_ = __builtin_amdgcn_s_memrealtime() + (unsigned long long)MISC[5] * PROBE_SCALE;
        while (__builtin_amdgcn_s_memrealtime() < t_end_) __builtin_amdgcn_s_sleep(8); }
#endif
#undef IN
#undef SEAM
}
constexpr int N_PHASES = 1 + NL * (2 + 4 + 2);

#ifndef MK_MULTI
#define MK_MULTI 0
#endif
extern "C" void kernel_launch(void* const* d_in, const int* in_sizes, int n_in, void* d_out, int out_size, void* d_ws, size_t ws_size, hipStream_t stream) {
    static int grid = 0;
    if (grid == 0) {
        if (n_in != 28 || in_sizes[0] != M * D || out_size != M * D || ws_size < WS_END) { fprintf(stderr, "kernel_launch: shape mismatch: n_in %d in0 %d out %d ws %zu (need %zu)\n", n_in, n_in > 0 ? in_sizes[0] : -1, out_size, ws_size, (size_t)WS_END); grid = -1; return; }
        int dev = 0, cus = 0, per_cu = 0;
        if (hipGetDevice(&dev) != hipSuccess || hipDeviceGetAttribute(&cus, hipDeviceAttributeMultiprocessorCount, dev) != hipSuccess) { fprintf(stderr, "kernel_launch: device query failed\n"); grid = -1; return; }
        if (hipFuncSetAttribute((const void*)fwd_kernel, hipFuncAttributeMaxDynamicSharedMemorySize, LDS_BYTES) != hipSuccess) { fprintf(stderr, "kernel_launch: hipFuncSetAttribute failed\n"); grid = -1; return; }
        if (hipOccupancyMaxActiveBlocksPerMultiprocessor(&per_cu, (const void*)fwd_kernel, NTHREADS, LDS_BYTES) != hipSuccess || per_cu < 1) fprintf(stderr, "kernel_launch: note: occupancy query reports %d workgroups per CU\n", per_cu);
        (void)hipGetLastError();
        grid = cus;
    }
    if (grid < 0) return;
    if (hipMemsetAsync((char*)d_ws + WS_CTL, 0, CTL_ZERO_BYTES, stream) != hipSuccess) { fprintf(stderr, "kernel_launch: memset failed\n"); return; }
    Args a{};
    for (int i = 0; i < 28; ++i) a.in[i] = (const float*)d_in[i];
    a.out = (float*)d_out; a.ws = (unsigned char*)d_ws;
#if MK_MULTI
    for (int p = 0; p < N_PHASES; ++p) { a.ph_lo = p; a.ph_hi = p + 1; hipLaunchKernelGGL(fwd_kernel, dim3(grid), dim3(NTHREADS), LDS_BYTES, stream, a); }
#else
    a.ph_lo = 0; a.ph_hi = N_PHASES;
    hipLaunchKernelGGL(fwd_kernel, dim3(grid), dim3(NTHREADS), LDS_BYTES, stream, a);
#endif
    const hipError_t le = hipPeekAtLastError();
    if (le != hipSuccess) fprintf(stderr, "kernel_launch: launch failed: %s\n", hipGetErrorName(le));
}
```

```cpp
#include <hip/hip_runtime.h>
#include <cstdio>
#include <cstdint>
__device__ __forceinline__ int ltid() { int t = (int)threadIdx.x; asm volatile("" : "+v"(t)); return t; }
#ifndef PG8_WGM
#define PG8_WGM 8
#endif
namespace pg8 {
#define PG8_LAS __attribute__((address_space(3)))
typedef unsigned short bf16_t;
typedef short bf16x8 __attribute__((ext_vector_type(8)));
typedef float f32x4 __attribute__((ext_vector_type(4)));
typedef unsigned u32x4 __attribute__((ext_vector_type(4)));
constexpr int BM = 256, BK = 64, HALF = 128, HTB = HALF * BK * 2  , STAGE_BYTES = 8 * HTB, NXCD = 8, WGM = PG8_WGM;

__host__ __device__ __forceinline__ int lds_byte(int r, int c) { const int st = (r >> 4) * 2 + (c >> 5), rr = r & 15, cc = c & 31, ob = rr * 64 + cc * 2; return st * 1024 + (ob ^ (((ob >> 9) & 1) << 5)); }
__host__ __device__ __forceinline__ void stage_rc(int b, int& R, int& C) { const int st = b / 1024, sb = b % 1024, swz = sb ^ (((sb >> 9) & 1) << 5); R = (st >> 1) * 16 + swz / 64; C = (st & 1) * 32 + (swz % 64) / 2; }
__host__ __device__ __forceinline__ int perm32(int rho) { const int n = rho >> 4, i = rho & 15; return 8 * (i >> 2) + 4 * n + (i & 3); }

struct Unit { int pm, pn; int k0 = 0, nk = 0, part = 0; };
struct Gemm { const bf16_t* A; const bf16_t* Bt; int M, N, K; int lda = 0; };

struct StaticOrder {
    int nM, nN, nwg, G, c;
    __host__ __device__ void init(int M, int N, int G_, int c_) { nM = M / BM; nN = N / BM; nwg = nM * nN; G = G_; c = c_; }
    __host__ __device__ bool next(int i, Unit& u) const {
        const long L = (long)i * G + c; if (L >= nwg) return false;
        int wgid = (int)L; { const int q = nwg / NXCD, r = nwg % NXCD, xcd = wgid % NXCD, off = wgid / NXCD; wgid = (xcd < r ? xcd * (q + 1) : r * (q + 1) + (xcd - r) * q) + off; }
        const int nig = WGM * nN, gid = wgid / nig, fm = gid * WGM, gsz = (nM - fm) < WGM ? (nM - fm) : WGM;
        u.pm = fm + ((wgid % nig) % gsz); u.pn = (wgid % nig) / gsz; return true;
    }
    __device__ __forceinline__ void a_ready(const Unit&) const {}
    __device__ __forceinline__ void done(const Unit&) const {}
};

typedef __attribute__((address_space(1))) unsigned gflag_t;
template <int NT, int KT, int CA, int CB, int CC, int LEADPOS_ = -1>
struct SplitOrder {
    static constexpr int R = NT % 4, NFULL = NT / 4, LEADPOS = LEADPOS_ < 0 ? NFULL - 1 : LEADPOS_;
    static_assert((R == 2 || R == 3) && CA % 2 == 0 && CB % 2 == 0 && CC % 2 == 0 && CA >= 2 && CA <= KT - 2 && KT % 2 == 0, "split shape");
    int c; unsigned char* slab; gflag_t* flags; gflag_t* tmo;
    __device__ __forceinline__ bool next(int i, Unit& u) const {
        const int j = c >> 6; int idx = i; int pm_ = ((c & 7) << 3) + ((c >> 3) & 7); asm volatile("" : "+s"(pm_));
        u.pm = pm_; u.k0 = 0; u.nk = KT; u.part = 0;
        const int lead_nk = R == 2 ? ((j & 1) ? 0 : CA) : (j == 0 ? CA : j == 1 ? CB : j == 2 ? CC : 0);
        const int lead_pn = 4 * NFULL + (R == 2 ? (j >> 1) : j);
        const int tail_k0 = R == 2 ? ((j & 1) ? CA : 0) : (j == 1 ? CA : j == 2 ? CB : j == 3 ? CC : 0);
        const int tail_pn = 4 * NFULL + (R == 2 ? (j >> 1) : j - 1);
        if (lead_nk) { if (idx == LEADPOS) { u.pn = lead_pn; u.nk = lead_nk; u.part = 1; return true; } if (idx > LEADPOS) --idx; }
        if (idx < NFULL) { u.pn = 4 * idx + j; return true; }
        if (idx == NFULL && tail_k0) { u.pn = tail_pn; u.k0 = tail_k0; u.nk = KT - tail_k0; u.part = 2; return true; }
        return false; }
    __device__ __forceinline__ int slot(const Unit& u) const { return u.pm * R + (u.pn - 4 * NFULL); }
    __device__ __forceinline__ void a_ready(const Unit&) const {}
    __device__ __forceinline__ void done(const Unit&) const {}
};
__device__ __forceinline__ unsigned cvt_pk_bf16(float lo, float hi) { unsigned r; asm volatile("v_cvt_pk_bf16_f32 %0, %1, %2" : "=v"(r) : "v"(lo), "v"(hi)); return r; }
template <class Epi, bool ON> struct AccInitRegs { typedef int type; };
template <class Epi> struct AccInitRegs<Epi, true> { typedef typename Epi::ResTile type; };
template <class Epi, class Sched, bool ALIGN_EPI = false, bool SP2 = false, int KREV = 0, int SPLITK = 0>
__device__ __forceinline__ void gemm_phase(PG8_LAS unsigned char* lds, const Gemm g, const Sched& S, const Epi& E) {
    const int tid = ltid(), wid = __builtin_amdgcn_readfirstlane(tid >> 6), lane = tid & 63, wr = wid >> 2, wc = wid & 3, fr = lane & 15, fq = lane >> 4;
    static_assert(!SPLITK || (ALIGN_EPI && KREV == 0 && !Epi::AFTER_DRAIN), "SPLITK needs ALIGN_EPI, KREV = 0, an in-stream epilogue");
    const int K = g.K, nt = K / BK, LDA = g.lda ? g.lda : K;
    unsigned voffA[2], voffB[2];
#pragma unroll
    for (int i = 0; i < 2; ++i) { int R, C; stage_rc(tid * 16 + i * 8192, R, C); const int Rb = Epi::PERM ? ((R & ~31) + perm32(R & 31)) : R;
        voffA[i] = (unsigned)(R * LDA + C) * 2u; voffB[i] = (unsigned)(Rb * K + C) * 2u; }
    const size_t kstep = (size_t)(BK * 2);
    const size_t hstep = (size_t)HALF * K * 2;
    const size_t tstep = 2 * hstep;
    const size_t hstepA = (size_t)HALF * LDA * 2, tstepA = 2 * hstepA;
    const unsigned ldsw = (unsigned)wid * 1024u;
    const int aoff = lds_byte(wr * 64 + fr, fq * 8), boff = lds_byte(wc * 32 + fr, fq * 8);
#define PG8_SA(b, h) (((b) * 2 + (h)) * HTB)
#define PG8_SB(b, h) ((4 + (b) * 2 + (h)) * HTB)
#define PG8_STAGE(bufoff, gbase, voff) do { _Pragma("unroll") for (int _i = 0; _i < 2; ++_i) \
        __builtin_amdgcn_global_load_lds((const unsigned*)((const char*)(gbase) + (voff)[_i]), (PG8_LAS unsigned*)(lds + (bufoff) + ldsw + _i * 8192), 16, 0, 0); } while (0)
#define PG8_LDA(dst, b, h) do { _Pragma("unroll") for (int m = 0; m < 4; ++m) _Pragma("unroll") for (int k = 0; k < 2; ++k) dst[m][k] = *(const PG8_LAS bf16x8*)(lds + PG8_SA(b, h) + aoff + m * 2048 + k * 1024); } while (0)
#define PG8_LDB(dst, b, h) do { _Pragma("unroll") for (int n = 0; n < 2; ++n) _Pragma("unroll") for (int k = 0; k < 2; ++k) dst[n][k] = *(const PG8_LAS bf16x8*)(lds + PG8_SB(b, h) + boff + n * 2048 + k * 1024); } while (0)
#define PG8_MMA(ai, bj, At, Bt) do { __builtin_amdgcn_s_setprio(1); _Pragma("unroll") for (int m = 0; m < 4; ++m) _Pragma("unroll") for (int n = 0; n < 2; ++n) _Pragma("unroll") for (int k = 0; k < 2; ++k) \
        acc[ai][bj][m][n] = __builtin_amdgcn_mfma_f32_16x16x32_bf16(Bt[n][k], At[m][k], acc[ai][bj][m][n], 0, 0, 0); __builtin_amdgcn_s_setprio(0); } while (0)
#define PG8_WAIT_V(n) asm volatile("s_waitcnt vmcnt(" #n ")" ::: "memory")
#define PG8_WAIT_L(n) asm volatile("s_waitcnt lgkmcnt(" #n ")" ::: "memory")
#define PG8_BAR __builtin_amdgcn_s_barrier()
#define PG8_SCHED __builtin_amdgcn_sched_barrier(0)
    Unit cur, nxt; int ui = 0;
    if (!S.next(0, cur)) return;
    f32x4 acc[2][2][4][2];
#pragma unroll
    for (int a = 0; a < 2; ++a)
#pragma unroll
        for (int b = 0; b < 2; ++b)
#pragma unroll
            for (int m = 0; m < 4; ++m)
#pragma unroll
                for (int n = 0; n < 2; ++n) acc[a][b][m][n] = (f32x4){0.f, 0.f, 0.f, 0.f};
    bf16x8 At[4][2], B0[2][2], B1[2][2];
    long cs = (KREV && ((ui & 1) == 0)) ? -(long)kstep : (long)kstep;
    int cnt = nt; if constexpr (SPLITK) cnt = cur.nk;
    const char* cA = (const char*)g.A + (size_t)cur.pm * tstepA + (cs < 0 ? (size_t)(nt - 1) * kstep : 0) + (SPLITK ? (size_t)cur.k0 * kstep : 0); const char* cB = (const char*)g.Bt + (size_t)cur.pn * tstep + (cs < 0 ? (size_t)(nt - 1) * kstep : 0) + (SPLITK ? (size_t)cur.k0 * kstep : 0);
    S.a_ready(cur);
    typename AccInitRegs<Epi, Epi::ACC_INIT>::type RR;
    if constexpr (Epi::ACC_INIT) E.prefetch(cur, wr, wc, fr, fq, RR);
    if constexpr (SP2) {
        PG8_STAGE(PG8_SB(0, 0), cB, voffB); PG8_STAGE(PG8_SB(0, 1), cB + hstep, voffB); PG8_STAGE(PG8_SA(0, 0), cA, voffA); PG8_STAGE(PG8_SA(0, 1), cA + hstepA, voffA);
        if (wr == 1) PG8_BAR;
        PG8_WAIT_V(2); PG8_BAR;
        PG8_STAGE(PG8_SB(1, 0), cB + cs, voffB); PG8_STAGE(PG8_SA(1, 0), cA + cs, voffA); PG8_STAGE(PG8_SB(1, 1), cB + hstep + cs, voffB);
        PG8_WAIT_V(6); PG8_BAR;
    } else {
        PG8_STAGE(PG8_SB(0, 0), cB, voffB); PG8_STAGE(PG8_SA(0, 0), cA, voffA); PG8_STAGE(PG8_SB(0, 1), cB + hstep, voffB); PG8_STAGE(PG8_SA(0, 1), cA + hstepA, voffA);
        if (wr == 1) PG8_BAR;
        PG8_WAIT_V(4); PG8_BAR;
        PG8_STAGE(PG8_SB(1, 0), cB + cs, voffB); PG8_STAGE(PG8_SA(1, 0), cA + cs, voffA); PG8_STAGE(PG8_SB(1, 1), cB + hstep + cs, voffB);
        PG8_WAIT_V(6); PG8_BAR;
    }
    if constexpr (Epi::ACC_INIT) E.init(acc, RR, cur, wr, wc, fr, fq);
    for (;;) {
        const bool has_next = S.next(ui + 1, nxt);
        const long ns = has_next ? ((KREV && (((ui + 1) & 1) == 0)) ? -(long)kstep : (long)kstep) : cs;
        const char* nA = has_next ? (const char*)g.A + (size_t)nxt.pm * tstepA + (ns < 0 ? (size_t)(nt - 1) * kstep : 0) + (SPLITK ? (size_t)nxt.k0 * kstep : 0) : cA; const char* nB = has_next ? (const char*)g.Bt + (size_t)nxt.pn * tstep + (ns < 0 ? (size_t)(nt - 1) * kstep : 0) + (SPLITK ? (size_t)nxt.k0 * kstep : 0) : cB;
        int ncnt = cnt; if constexpr (SPLITK) { if (has_next) ncnt = nxt.nk; }
        for (int t = 0; t < cnt; t += 2) {
            const bool last = (t == cnt - 2);
            const char* a1 = cA + (long)(t + 1) * cs;
            const char* a2 = last ? nA : cA + (long)(t + 2) * cs; const char* b2 = last ? nB : cB + (long)(t + 2) * cs;
            const long s3 = last ? ns : cs; const char* a3 = a2 + s3; const char* b3 = b2 + s3;
            if (last && has_next) S.a_ready(nxt);
            if constexpr (SP2) {
            PG8_LDB(B0, 0, 0); PG8_LDB(B1, 0, 1); PG8_SCHED; PG8_LDA(At, 0, 0); PG8_STAGE(PG8_SA(1, 1), a1 + hstepA, voffA);
            PG8_WAIT_V(8); PG8_WAIT_L(0); PG8_BAR; PG8_MMA(0, 0, At, B0); PG8_MMA(0, 1, At, B1); PG8_BAR; PG8_SCHED;
            PG8_LDA(At, 0, 1); PG8_STAGE(PG8_SB(0, 0), b2, voffB); PG8_STAGE(PG8_SB(0, 1), b2 + hstep, voffB); PG8_STAGE(PG8_SA(0, 0), a2, voffA);
            PG8_WAIT_V(8); PG8_WAIT_L(0); PG8_BAR; PG8_MMA(1, 0, At, B0); PG8_MMA(1, 1, At, B1); PG8_BAR; PG8_SCHED;
            PG8_LDB(B0, 1, 0); PG8_LDB(B1, 1, 1); PG8_SCHED; PG8_LDA(At, 1, 0); PG8_STAGE(PG8_SA(0, 1), a2 + hstepA, voffA);
            PG8_WAIT_V(8); PG8_WAIT_L(0); PG8_BAR; PG8_MMA(0, 0, At, B0); PG8_MMA(0, 1, At, B1); PG8_BAR; PG8_SCHED;
            PG8_LDA(At, 1, 1); PG8_STAGE(PG8_SB(1, 0), b3, voffB); PG8_STAGE(PG8_SB(1, 1), b3 + hstep, voffB); PG8_STAGE(PG8_SA(1, 0), a3, voffA);
            PG8_WAIT_V(8); PG8_WAIT_L(0); PG8_BAR; PG8_MMA(1, 0, At, B0); PG8_MMA(1, 1, At, B1); PG8_BAR; PG8_SCHED;
            } else {
            PG8_LDB(B0, 0, 0); PG8_SCHED; PG8_LDA(At, 0, 0); PG8_STAGE(PG8_SA(1, 1), a1 + hstepA, voffA);
            PG8_WAIT_L(8); PG8_BAR; PG8_WAIT_L(0); PG8_MMA(0, 0, At, B0); PG8_BAR; PG8_SCHED;
            PG8_LDB(B1, 0, 1); PG8_STAGE(PG8_SB(0, 0), b2, voffB);
            PG8_BAR; PG8_WAIT_L(0); PG8_MMA(0, 1, At, B1); PG8_BAR;
            PG8_LDA(At, 0, 1); PG8_STAGE(PG8_SA(0, 0), a2, voffA);
            PG8_BAR; PG8_WAIT_L(0); PG8_MMA(1, 0, At, B0); PG8_BAR; PG8_SCHED;
            PG8_STAGE(PG8_SB(0, 1), b2 + hstep, voffB);
            PG8_WAIT_V(6); PG8_BAR; PG8_MMA(1, 1, At, B1); PG8_BAR;
            PG8_LDB(B0, 1, 0); PG8_SCHED; PG8_LDA(At, 1, 0); PG8_STAGE(PG8_SA(0, 1), a2 + hstepA, voffA);
            PG8_WAIT_L(8); PG8_BAR; PG8_WAIT_L(0); PG8_MMA(0, 0, At, B0); PG8_BAR; PG8_SCHED;
            PG8_LDB(B1, 1, 1); PG8_STAGE(PG8_SB(1, 0), b3, voffB);
            PG8_BAR; PG8_WAIT_L(0); PG8_MMA(0, 1, At, B1); PG8_BAR;
            PG8_LDA(At, 1, 1); PG8_STAGE(PG8_SA(1, 0), a3, voffA);
            PG8_BAR; PG8_WAIT_L(0); PG8_MMA(1, 0, At, B0); PG8_BAR; PG8_SCHED;
            PG8_STAGE(PG8_SB(1, 1), b3 + hstep, voffB);
            PG8_WAIT_V(6); PG8_BAR; PG8_MMA(1, 1, At, B1); PG8_BAR;
            }
        }
        if constexpr (ALIGN_EPI) { if (wr == 0) PG8_BAR; }
        if constexpr (Epi::ACC_INIT) { if (has_next) E.prefetch(nxt, wr, wc, fr, fq, RR); }
        if constexpr (SPLITK) {
            if (cur.part == 1) {
                const __amdgpu_buffer_rsrc_t rs_ = __builtin_amdgcn_make_buffer_rsrc((void*)(S.slab + (size_t)S.slot(cur) * 262144), (short)0, 262144, 0x00020000);
#pragma unroll
                for (int q = 0; q < 32; ++q) __builtin_amdgcn_raw_buffer_store_b128(__builtin_bit_cast(u32x4, acc[q >> 4][(q >> 3) & 1][(q >> 1) & 3][q & 1]), rs_, (unsigned)tid * 16u, q * 8192,   16);
                asm volatile("s_waitcnt vmcnt(0)" ::: "memory"); PG8_BAR;
                if (tid == 0) __hip_atomic_store(S.flags + (S.slot(cur) << 4), 1u, __ATOMIC_RELAXED, __HIP_MEMORY_SCOPE_AGENT);
            } else {
                E(acc, cur, wr, wc, fr, fq);
            }
            S.done(cur);
        } else
        if constexpr (!Epi::AFTER_DRAIN) { E(acc, cur, wr, wc, fr, fq);
#if defined(REP_EPI)
            if constexpr (Epi::REPEATABLE) E(acc, cur, wr, wc, fr, fq);
#endif
            S.done(cur); }
        if (!has_next) break;
        bool from_slab = false;
        if constexpr (SPLITK) from_slab = nxt.part == 2;
        if (from_slab) {
            if constexpr (SPLITK) {
                if (tid == 0) { unsigned sp_ = 0;
                    while (__hip_atomic_load(S.flags + (S.slot(nxt) << 4), __ATOMIC_RELAXED, __HIP_MEMORY_SCOPE_AGENT) == 0u) { __builtin_amdgcn_s_sleep(1);
                        if ((++sp_ & 255u) == 0u) { if (__hip_atomic_load(S.tmo, __ATOMIC_RELAXED, __HIP_MEMORY_SCOPE_AGENT)) break;
                            if (sp_ > (1u << 21)) { __hip_atomic_fetch_add(S.tmo, 1u, __ATOMIC_RELAXED, __HIP_MEMORY_SCOPE_AGENT); break; } } } }
                PG8_BAR;
                const __amdgpu_buffer_rsrc_t rs_ = __builtin_amdgcn_make_buffer_rsrc((void*)(S.slab + (size_t)S.slot(nxt) * 262144), (short)0, 262144, 0x00020000);
                float one_ = 1.0f; asm volatile("" : "+v"(one_));
#pragma unroll
                for (int q = 0; q < 32; ++q) acc[q >> 4][(q >> 3) & 1][(q >> 1) & 3][q & 1] = __builtin_bit_cast(f32x4, __builtin_amdgcn_raw_buffer_load_b128(rs_, (unsigned)tid * 16u, q * 8192,   16)) * one_;
            }
        } else if constexpr (Epi::ACC_INIT) { E.init(acc, RR, nxt, wr, wc, fr, fq);
        } else {
#pragma unroll
        for (int a = 0; a < 2; ++a)
#pragma unroll
            for (int b = 0; b < 2; ++b)
#pragma unroll
                for (int m = 0; m < 4; ++m)
#pragma unroll
                    for (int n = 0; n < 2; ++n) acc[a][b][m][n] = (f32x4){0.f, 0.f, 0.f, 0.f};
        }
        cur = nxt; cA = nA; cB = nB; cs = ns; cnt = ncnt; ++ui;
        if constexpr (ALIGN_EPI) { if (wr == 1) PG8_BAR; }
    }
    PG8_WAIT_V(0);
    if constexpr (!ALIGN_EPI) { if (wr == 0) PG8_BAR; }
    PG8_BAR;
    if constexpr (Epi::AFTER_DRAIN) { E.fused(acc, cur, wr, wc, fr, fq, lds, wid, lane); S.done(cur); }
#undef PG8_SA
#undef PG8_SB
#undef PG8_STAGE
#undef PG8_LDA
#undef PG8_LDB
#undef PG8_MMA
#undef PG8_WAIT_V
#undef PG8_WAIT_L
#undef PG8_BAR
#undef PG8_SCHED
}
}
#define GAS __attribute__((address_space(1)))
#define LAS __attribute__((address_space(3)))
typedef unsigned short bf16;
typedef unsigned v4u __attribute__((ext_vector_type(4)));
typedef float f32x4 __attribute__((ext_vector_type(4)));
typedef short bf16x8 __attribute__((ext_vector_type(8)));
typedef GAS unsigned gu32;
typedef GAS unsigned long long gu64;
#define RLX_AGENT __ATOMIC_RELAXED, __HIP_MEMORY_SCOPE_AGENT
#define LDS_WAIT() asm volatile("s_waitcnt lgkmcnt(0)" ::: "memory")
#define VM_WAIT() asm volatile("s_waitcnt vmcnt(0)" ::: "memory")
__device__ __forceinline__ unsigned long long rt() { return __builtin_amdgcn_s_memrealtime(); }

#define XB_TMO      128
#define XB_XCNT(j)  (256  + 64 * (j))
#define XB_XSUB(j)  (1280 + 64 * (j))
#define XB_XGEN(j)  (2304 + 64 * (j))
#define XB_TOP      3328
#define XB_TOPGEN   3392
#define XCD_BAR_WORDS 3456
#define XB_SPIN_CAP (1u << 21)

__device__ __forceinline__ unsigned xb_ld(unsigned* p)              { return __hip_atomic_load(p, __ATOMIC_RELAXED, __HIP_MEMORY_SCOPE_AGENT); }
__device__ __forceinline__ unsigned xb_add(unsigned* p, unsigned v) { return __hip_atomic_fetch_add(p, v, __ATOMIC_RELAXED, __HIP_MEMORY_SCOPE_AGENT); }
__device__ __forceinline__ unsigned xb_xcc_id() { return (unsigned)__builtin_amdgcn_s_getreg((3 << 11) | 20) & 0xFu; }
#define XB_SPIN(cond, bar) do { unsigned _sp = 0; while (cond) { __builtin_amdgcn_s_sleep(1); \
    if ((++_sp & 255u) == 0u) { if (xb_ld(&(bar)[XB_TMO])) break; if (_sp > XB_SPIN_CAP) { atomicAdd(&(bar)[XB_TMO], 1u); break; } } } } while (0)

struct XcdBarrier {
    unsigned* bar; unsigned x;
    volatile LAS unsigned* st;
};

__device__ __forceinline__ XcdBarrier xcd_barrier_post(unsigned* bar, volatile LAS unsigned* st) {
    XcdBarrier b; b.bar = bar; b.x = xb_xcc_id(); b.st = st;
    if (threadIdx.x == 0) (void)xb_add(&bar[XB_XCNT(b.x)], 1u);
    return b;
}
__device__ __forceinline__ void xcd_barrier_complete(unsigned* bar, unsigned x, unsigned& nloc, unsigned& nx) {
    const unsigned G = gridDim.x * gridDim.y * gridDim.z;
    unsigned sum, cnt, mine, sp = 0u;
    for (;;) {
        sum = 0u; cnt = 0u; mine = 0u;
#pragma unroll
        for (unsigned j = 0; j < 16; ++j) { const unsigned c = xb_ld(&bar[XB_XCNT(j)]); sum += c; cnt += (c > 0u) ? 1u : 0u; mine = (j == x) ? c : mine; }
        if (sum == G) break;
        __builtin_amdgcn_s_sleep(1);
        if ((++sp & 255u) == 0u) { if (xb_ld(&bar[XB_TMO])) break; if (sp > XB_SPIN_CAP) { atomicAdd(&bar[XB_TMO], 1u); break; } }
    }
    nloc = mine > 0u ? mine : 1u; nx = cnt > 0u ? cnt : 1u;
}

__device__ __forceinline__ void xcd_barrier(const XcdBarrier& b) {
    asm volatile("s_waitcnt vmcnt(0)" ::: "memory");
    __syncthreads();
    if (threadIdx.x == 0) {
        unsigned* bar = b.bar;
        __builtin_amdgcn_s_waitcnt(0);
        unsigned nloc = b.st[0], nx = b.st[1];
        if (nloc == 0u) { xcd_barrier_complete(bar, b.x, nloc, nx); b.st[0] = nloc; b.st[1] = nx; }
        const unsigned old = xb_add(&bar[XB_XSUB(b.x)], 1u);
        const unsigned gen = old / nloc;
        if (old + 1u == (gen + 1u) * nloc) {
            __builtin_amdgcn_fence(__ATOMIC_RELEASE, "agent");
            asm volatile("s_waitcnt vmcnt(0)" ::: "memory");
            const unsigned og = xb_add(&bar[XB_TOP], 1u);
            const unsigned tg = og / nx;
            if (og + 1u == (tg + 1u) * nx) xb_add(&bar[XB_TOPGEN], 1u);
            else XB_SPIN(xb_ld(&bar[XB_TOPGEN]) == tg, bar);
            __builtin_amdgcn_fence(__ATOMIC_ACQUIRE, "agent");
            xb_add(&bar[XB_XGEN(b.x)], 1u);
            asm volatile("s_waitcnt vmcnt(0)" ::: "memory");
        } else {
            XB_SPIN(xb_ld(&bar[XB_XGEN(b.x)]) == gen, bar);
            __builtin_amdgcn_fence(__ATOMIC_ACQUIRE, "agent");
            asm volatile("s_waitcnt vmcnt(0)" ::: "memory");
        }
    }
    __syncthreads();
}

#define DI __device__ __forceinline__
typedef float f32x2 __attribute__((ext_vector_type(2)));
typedef __bf16 bf16x2_t __attribute__((ext_vector_type(2)));
typedef float f32x16 __attribute__((ext_vector_type(16)));
typedef short s16x4 __attribute__((ext_vector_type(4)));
constexpr int NWAVES = 8, NTHREADS = 512;
constexpr int BATCH = 4, SEQ = 4096, M = BATCH * SEQ, D = 2048, F = 5504, NGU = 2 * F, NL = 4;
constexpr int PIN = 5440, PINP = 5632;
constexpr int HP = PINP;
constexpr int HGW = 768, UQN = 1152, UKVN = 1536;
constexpr float EPS = 1e-6f;
constexpr float LOG2E = 1.4426950408889634f;
constexpr int C_HQ = 0, C_HF = 768, C_HI = 1536, C_HG = 2304, C_DQ = 3072, C_DK = 3584, C_DV = 4096, C_CQ = 4608, C_CKV = 5120, C_KR = 5376;
constexpr int MX_HG = 0, MX_DF = 768, MX_ML = 1280;
constexpr float SC_HQ = 0.08838834764831845f;
constexpr float SC_DQ = 0.125f * LOG2E;
constexpr float SC_MQ = 0.07216878364870322f * LOG2E;

constexpr size_t MiB = 1u << 20;
constexpr size_t WS_CTL = 0, CTL_ZERO_BYTES = 1 * MiB;
constexpr size_t WS_CONST = 1 * MiB;
constexpr size_t CO_LB = 0, CO_LAM = 16384, CO_BIAS = 20480, CO_ROPE = 65536;
constexpr size_t WS_W = 4 * MiB;
constexpr size_t SZ_GU = (size_t)NGU * D * 2, SZ_DN = (size_t)D * F * 2, SZ_IN = (size_t)PINP * D * 2, SZ_OUT = (size_t)D * D * 2, SZ_UQ = (size_t)UQN * 512 * 2, SZ_UKV = (size_t)UKVN * 256 * 2;
constexpr size_t WO_GUA = 0, WO_DA = WO_GUA + SZ_GU, WO_IN = WO_DA + SZ_DN, WO_OUT = WO_IN + SZ_IN, WO_UQ = WO_OUT + SZ_OUT, WO_UKV = WO_UQ + SZ_UQ, WO_GUB = WO_UKV + SZ_UKV, WO_DB = WO_GUB + SZ_GU, W_LAYER = WO_DB + SZ_DN;
constexpr size_t WS_XB = WS_W + NL * W_LAYER;
constexpr size_t WS_STATS = WS_XB + (size_t)M * D * 2;
constexpr size_t WS_A = WS_STATS + (size_t)M * 32 * 4;
constexpr size_t WS_LF = WS_A + (size_t)M * PINP * 2;
constexpr size_t WS_QI = WS_LF + (size_t)M * HGW * 4;
constexpr size_t WS_P = WS_QI + (size_t)M * HGW * 2;
constexpr size_t WS_KDT = WS_P + (size_t)1536 * 4096 * 2;
constexpr size_t WS_VT = WS_KDT + (size_t)M * HGW * 2;
constexpr size_t WS_DEC = WS_VT + (size_t)M * HGW * 2;
constexpr size_t WS_QM = WS_DEC + 1 * MiB;
constexpr size_t WS_KM = WS_QM + (size_t)M * UQN * 2;
constexpr size_t WS_VM = WS_KM + (size_t)M * UQN * 2;
constexpr size_t WS_QN = WS_VM + (size_t)M * 768 * 2;
constexpr size_t WS_KN = WS_QN + (size_t)M * 512 * 2;
constexpr size_t WS_SCR = WS_KN + (size_t)M * 512 * 2;
constexpr size_t WS_MIX = WS_SCR + (size_t)256 * 256 * 128 * 4;
constexpr size_t WS_XL = WS_MIX + (size_t)M * D * 2;
constexpr size_t WS_SLAB = WS_XL + (size_t)M * D * 2;
#ifndef SPLITK_SLABS
#define SPLITK_SLABS 0
#endif
constexpr size_t WS_END = WS_SLAB + (size_t)SPLITK_SLABS * 262144;
static_assert(WS_XB % 256 == 0 && WS_A % 256 == 0 && WS_QM % 256 == 0 && WS_MIX % 256 == 0, "ws map alignment");
constexpr int CW_BAR = 4096;
constexpr int CW_Q = 16384;
constexpr int CW_XCC = 49152, CW_NONLOCAL = 49152 + 512;
constexpr int CW_SPL = 65536;
static_assert((size_t)(CW_SPL + 12 * 192 * 16) * 4 <= CTL_ZERO_BYTES, "flag words inside the per-call memset");

constexpr int LDSCTL_OFF = 0, MISC_OFF = 320, RING_OFF = 1024, LDS_BYTES = 147456, RING_BYTES = LDS_BYTES - RING_OFF;

DI unsigned pk2(float lo, float hi) { f32x2 v = {lo, hi}; bf16x2_t b = __builtin_convertvector(v, bf16x2_t); return __builtin_bit_cast(unsigned, b); }
DI float bflo(unsigned w) { return __uint_as_float(w << 16); }
DI float bfhi(unsigned w) { return __uint_as_float(w & 0xffff0000u); }
DI float bf2f(unsigned short b) { return __uint_as_float(((unsigned)b) << 16); }
DI float wave_sum(float v) {
#pragma unroll
    for (int o = 1; o < 64; o <<= 1) v += __shfl_xor(v, o);
    return v;
}
DI float ex2(float x) { return __builtin_amdgcn_exp2f(x); }
DI float fexp(float x) { return __builtin_amdgcn_exp2f(x * LOG2E); }
DI float fsigmoid(float x) { return __builtin_amdgcn_rcpf(1.f + fexp(-x)); }
DI float frsqrt(float x) { return __builtin_amdgcn_rsqf(x); }
DI bf16x8 mk8(unsigned a, unsigned b, unsigned c, unsigned d) { v4u w = {a, b, c, d}; return __builtin_bit_cast(bf16x8, w); }
DI f32x4 mfma16(bf16x8 a, bf16x8 b, f32x4 c) { return __builtin_amdgcn_mfma_f32_16x16x32_bf16(a, b, c, 0, 0, 0); }

DI void load_rs(const float* stats, int row0, int fq, float (&rs)[2][4]) {
#pragma unroll
    for (int ai = 0; ai < 2; ++ai)
#pragma unroll
        for (int m = 0; m < 4; ++m) { const f32x4* p = (const f32x4*)(stats + (size_t)(row0 + ai * 128 + m * 16) * 32 + 8 * fq); const f32x4 a = p[0], b = p[1];
            float s = ((a[0] + a[1]) + (a[2] + a[3])) + ((b[0] + b[1]) + (b[2] + b[3])); s += __shfl_xor(s, 16); s += __shfl_xor(s, 32); rs[ai][m] = frsqrt(s * (1.0f / D) + EPS); }
}
#ifndef H_NT
#define H_NT 0
#endif
struct EpiSwiGLU {
    static constexpr bool PERM = true, AFTER_DRAIN = false, REPEATABLE = false, ACC_INIT = false;
    bf16* H; const float* stats; mutable float rs[2][4]; mutable int last_pm;
    DI void operator()(const pg8::f32x4 (&acc)[2][2][4][2], const pg8::Unit& u, int wr, int wc, int fr, int fq) const {
        const int row0 = u.pm * 256 + wr * 64 + fr, col0 = u.pn * 128 + wc * 32 + 8 * fq;
        if (u.pm != last_pm) { load_rs(stats, row0, fq, rs); last_pm = u.pm; }
#pragma unroll
        for (int ai = 0; ai < 2; ++ai)
#pragma unroll
            for (int m = 0; m < 4; ++m) { const float r = rs[ai][m]; float hv[8];
#pragma unroll
                for (int n = 0; n < 2; ++n)
#pragma unroll
                    for (int j = 0; j < 4; ++j) { const float g = acc[ai][0][m][n][j] * r, up = acc[ai][1][m][n][j] * r; hv[4 * n + j] = g * fsigmoid(g) * up; }
                v4u w; w.x = pk2(hv[0], hv[1]); w.y = pk2(hv[2], hv[3]); w.z = pk2(hv[4], hv[5]); w.w = pk2(hv[6], hv[7]);
                if (H_NT) __builtin_nontemporal_store(w, (v4u*)(H + (size_t)(row0 + ai * 128 + m * 16) * HP + col0)); else *(v4u*)(H + (size_t)(row0 + ai * 128 + m * 16) * HP + col0) = w; }
    }
};
#ifndef RESID_LO
#define RESID_LO 0
#endif
#ifndef RES_AHEAD
#define RES_AHEAD 3
#endif
#ifndef RESID_ACC_INIT
#define RESID_ACC_INIT 0
#endif
#ifndef RESID_DEPTH
#define RESID_DEPTH 3
#endif
struct EpiResid {
    static constexpr bool PERM = true, AFTER_DRAIN = false, REPEATABLE = false, ACC_INIT = RESID_ACC_INIT;
    float* OUT; bf16* XB; bf16* XL; float* stats; float alpha; bool final;
    typedef v4u ResTile[RES_AHEAD][2];
    DI void prefetch(const pg8::Unit& u, int wr, int wc, int fr, int fq, ResTile& R) const {
        const int row0 = u.pm * 256 + wr * 64 + fr, col0 = u.pn * 256 + wc * 32 + 8 * fq;
        const __amdgpu_buffer_rsrc_t rx = __builtin_amdgcn_make_buffer_rsrc((void*)XB, (short)0, M * D * 2, 0x00020000);
        const unsigned voff = (unsigned)(row0 * D + col0) * 2u;
#pragma unroll
        for (int g = 0; g < RES_AHEAD; ++g)
#pragma unroll
            for (int bj = 0; bj < 2; ++bj) R[g][bj] = __builtin_amdgcn_raw_buffer_load_b128(rx, voff, (((g >> 2) * 128 + (g & 3) * 16) * D + bj * 128) * 2, 0);
    }
    DI void init(pg8::f32x4 (&acc)[2][2][4][2], const ResTile& R, const pg8::Unit& u, int wr, int wc, int fr, int fq) const {
        const float ia = 1.0f / alpha;
        const int row0 = u.pm * 256 + wr * 64 + fr, col0 = u.pn * 256 + wc * 32 + 8 * fq;
        const __amdgpu_buffer_rsrc_t rx = __builtin_amdgcn_make_buffer_rsrc((void*)XB, (short)0, M * D * 2, 0x00020000);
        const unsigned voff = (unsigned)(row0 * D + col0) * 2u;
        v4u R2[8 - RES_AHEAD][2];
#pragma unroll
        for (int g = RES_AHEAD; g < 8; ++g)
#pragma unroll
            for (int bj = 0; bj < 2; ++bj) R2[g - RES_AHEAD][bj] = __builtin_amdgcn_raw_buffer_load_b128(rx, voff, (((g >> 2) * 128 + (g & 3) * 16) * D + bj * 128) * 2, 0);
#pragma unroll
        for (int g = 0; g < 8; ++g)
#pragma unroll
            for (int bj = 0; bj < 2; ++bj) { v4u h; if (g < RES_AHEAD) h = R[g < RES_AHEAD ? g : 0][bj]; else h = R2[g >= RES_AHEAD ? g - RES_AHEAD : 0][bj];
                acc[g >> 2][bj][g & 3][0] = (pg8::f32x4){bflo(h.x) * ia, bfhi(h.x) * ia, bflo(h.y) * ia, bfhi(h.y) * ia};
                acc[g >> 2][bj][g & 3][1] = (pg8::f32x4){bflo(h.z) * ia, bfhi(h.z) * ia, bflo(h.w) * ia, bfhi(h.w) * ia}; }
    }
    DI void operator()(const pg8::f32x4 (&acc)[2][2][4][2], const pg8::Unit& u, int wr, int wc, int fr, int fq) const {
        const int row0 = u.pm * 256 + wr * 64 + fr, col0 = u.pn * 256 + wc * 32 + 8 * fq;
        if constexpr (ACC_INIT) {
            static_assert(!RESID_ACC_INIT || !RESID_LO, "ACC_INIT keeps the residual in bf16 only");
            const __amdgpu_buffer_rsrc_t rx = __builtin_amdgcn_make_buffer_rsrc((void*)XB, (short)0, M * D * 2, 0x00020000);
            const __amdgpu_buffer_rsrc_t ro = __builtin_amdgcn_make_buffer_rsrc((void*)OUT, (short)0, M * D * 4, 0x00020000);
            const unsigned voff = (unsigned)(row0 * D + col0) * 2u;
#pragma unroll
            for (int g = 0; g < 8; ++g) { const int ai = g >> 2, m = g & 3, row = row0 + ai * 128 + m * 16; float ss = 0.f;
#pragma unroll
                for (int bj = 0; bj < 2; ++bj) { const int so = ((ai * 128 + m * 16) * D + bj * 128) * 2;
                    const f32x4 x0 = acc[ai][bj][m][0] * alpha, x1 = acc[ai][bj][m][1] * alpha;
                    if (final) { __builtin_amdgcn_raw_buffer_store_b128(__builtin_bit_cast(v4u, x0), ro, voff * 2u, so * 2, 0); __builtin_amdgcn_raw_buffer_store_b128(__builtin_bit_cast(v4u, x1), ro, voff * 2u, so * 2 + 16, 0); }
                    else {
                        ss += (x0[0] * x0[0] + x0[1] * x0[1]) + (x0[2] * x0[2] + x0[3] * x0[3]) + (x1[0] * x1[0] + x1[1] * x1[1]) + (x1[2] * x1[2] + x1[3] * x1[3]);
                        v4u w; w.x = pk2(x0[0], x0[1]); w.y = pk2(x0[2], x0[3]); w.z = pk2(x1[0], x1[1]); w.w = pk2(x1[2], x1[3]);
                        __builtin_amdgcn_raw_buffer_store_b128(w, rx, voff, so, 0); } }
                if (!final) { ss += __shfl_xor(ss, 16); ss += __shfl_xor(ss, 32);
                    if (fq == 0) stats[(size_t)row * 32 + u.pn * 4 + wc] = ss; } }
            return;
        }
        v4u rh[RESID_DEPTH][2], rl[RESID_DEPTH][2];
#define RLOAD(buf, g) do { const size_t o_ = (size_t)(row0 + ((g) >> 2) * 128 + ((g) & 3) * 16) * D + col0; \
    rh[buf][0] = *(const v4u*)(XB + o_); rh[buf][1] = *(const v4u*)(XB + o_ + 128); if (RESID_LO) { rl[buf][0] = *(const v4u*)(XL + o_); rl[buf][1] = *(const v4u*)(XL + o_ + 128); } else { rl[buf][0] = rl[buf][1] = (v4u){0u, 0u, 0u, 0u}; } } while (0)
#pragma unroll
        for (int g = 0; g < RESID_DEPTH; ++g) RLOAD(g, g);
#pragma unroll
        for (int g = 0; g < 8; ++g) { const int ai = g >> 2, m = g & 3, row = row0 + ai * 128 + m * 16; float ss = 0.f;
            __builtin_amdgcn_sched_barrier(0);
#pragma unroll
            for (int bj = 0; bj < 2; ++bj) { const size_t off = (size_t)row * D + col0 + bj * 128;
                const v4u h = rh[g % RESID_DEPTH][bj], lo = rl[g % RESID_DEPTH][bj];
                f32x4 x0 = {bflo(h.x) + bflo(lo.x), bfhi(h.x) + bfhi(lo.x), bflo(h.y) + bflo(lo.y), bfhi(h.y) + bfhi(lo.y)};
                f32x4 x1 = {bflo(h.z) + bflo(lo.z), bfhi(h.z) + bfhi(lo.z), bflo(h.w) + bflo(lo.w), bfhi(h.w) + bfhi(lo.w)};
                x0 = x0 + acc[ai][bj][m][0] * alpha; x1 = x1 + acc[ai][bj][m][1] * alpha;
                if (final) { *(f32x4*)(OUT + off) = x0; *(f32x4*)(OUT + off + 4) = x1; }
                else {
                    ss += (x0[0] * x0[0] + x0[1] * x0[1]) + (x0[2] * x0[2] + x0[3] * x0[3]) + (x1[0] * x1[0] + x1[1] * x1[1]) + (x1[2] * x1[2] + x1[3] * x1[3]);
                    v4u w; w.x = pk2(x0[0], x0[1]); w.y = pk2(x0[2], x0[3]); w.z = pk2(x1[0], x1[1]); w.w = pk2(x1[2], x1[3]);
                    v4u l2; l2.x = pk2(x0[0] - bflo(w.x), x0[1] - bfhi(w.x)); l2.y = pk2(x0[2] - bflo(w.y), x0[3] - bfhi(w.y)); l2.z = pk2(x1[0] - bflo(w.z), x1[1] - bfhi(w.z)); l2.w = pk2(x1[2] - bflo(w.w), x1[3] - bfhi(w.w));
                    *(v4u*)(XB + off) = w; if (RESID_LO) *(v4u*)(XL + off) = l2; } }
            if (!final) { ss += __shfl_xor(ss, 16); ss += __shfl_xor(ss, 32);
                if (fq == 0) stats[(size_t)row * 32 + u.pn * 4 + wc] = ss; }
            __builtin_amdgcn_sched_barrier(0);
            if (g + RESID_DEPTH < 8) RLOAD(g % RESID_DEPTH, g + RESID_DEPTH); }
#undef RLOAD
    }
};
struct EpiProj {
    static constexpr bool PERM = true, AFTER_DRAIN = false, REPEATABLE = false, ACC_INIT = false;
    bf16* P; float* LF; const float* stats; const float* lb;
    mutable float rs[2][4]; mutable int last_pm;
    DI void operator()(const pg8::f32x4 (&acc)[2][2][4][2], const pg8::Unit& u, int wr, int wc, int fr, int fq) const {
        const int row0 = u.pm * 256 + wr * 64 + fr, col0 = u.pn * 256 + wc * 32 + 8 * fq;
        if (u.pm != last_pm) { load_rs(stats, row0, fq, rs); last_pm = u.pm; }
        const int seg = u.pn < 3 ? 0 : (u.pn < 6 ? 1 : (u.pn < 9 ? 2 : (u.pn < 12 ? 3 : 4)));
#pragma unroll
        for (int bj = 0; bj < 2; ++bj) { const int col = col0 + bj * 128;
            float lbv[8];
            if (seg == 1) { const f32x4 a = *(const f32x4*)(lb + col - C_HF), b = *(const f32x4*)(lb + col - C_HF + 4); lbv[0] = a[0]; lbv[1] = a[1]; lbv[2] = a[2]; lbv[3] = a[3]; lbv[4] = b[0]; lbv[5] = b[1]; lbv[6] = b[2]; lbv[7] = b[3]; }
            else {
#pragma unroll
                for (int j = 0; j < 8; ++j) lbv[j] = 0.f; }
#pragma unroll
            for (int ai = 0; ai < 2; ++ai)
#pragma unroll
                for (int m = 0; m < 4; ++m) { const int row = row0 + ai * 128 + m * 16; const float r = rs[ai][m]; float v[8];
#pragma unroll
                    for (int n = 0; n < 2; ++n)
#pragma unroll
                        for (int j = 0; j < 4; ++j) v[4 * n + j] = acc[ai][bj][m][n][j] * r;
                    if (seg == 0) {
#pragma unroll
                        for (int j = 0; j < 8; ++j) v[j] *= SC_HQ; }
                    else if (seg == 1) { float lf[8];
#pragma unroll
                        for (int j = 0; j < 8; ++j) { const float f = lbv[j] + (1.f - lbv[j]) * fsigmoid(v[j]); lf[j] = __builtin_amdgcn_logf(f) * 0.6931471805599453f; v[j] = 1.f - f; }
                        float* lp = LF + (size_t)row * HGW + col - C_HF; *(f32x4*)lp = (f32x4){lf[0], lf[1], lf[2], lf[3]}; *(f32x4*)(lp + 4) = (f32x4){lf[4], lf[5], lf[6], lf[7]}; }
                    else if (seg == 3) {
#pragma unroll
                        for (int j = 0; j < 8; ++j) v[j] = v[j] * fsigmoid(v[j]); }
                    v4u w; w.x = pk2(v[0], v[1]); w.y = pk2(v[2], v[3]); w.z = pk2(v[4], v[5]); w.w = pk2(v[6], v[7]);
                    *(v4u*)(P + (size_t)row * PINP + col) = w; }
        }
    }
};

#ifndef ATT_STAGGER
#define ATT_STAGGER 0
#endif
namespace att {
constexpr int KVBLK = 64, QBLK = 32, DV = 128;
constexpr int SHM_V = KVBLK * DV * 2;
constexpr float THR2 = 8.f * LOG2E;
template <int DQK> struct Cfg {
    static constexpr int KROW = DQK * 2 + 16, SHM_K = KVBLK * KROW, KCH = DQK / 64, CPR = DQK / 8;
    static constexpr int NSLOT = 3, OFF_V = 0, OFF_K = NSLOT * SHM_V, OFF_WS = OFF_K + NSLOT * SHM_K, OFF_BIAS = OFF_WS + NWAVES * 64 * 4, BYTES = OFF_BIAS + 1024;
};
static_assert(Cfg<192>::BYTES <= RING_BYTES, "attention LDS");
#define SBAR() __builtin_amdgcn_sched_barrier(0)
DI int crow(int r, int hi) { return (r & 3) + 8 * (r >> 2) + 4 * hi; }
DI unsigned cvtpk(float lo, float hi) { unsigned r; asm volatile("v_cvt_pk_bf16_f32 %0, %1, %2" : "=v"(r) : "v"(lo), "v"(hi)); return r; }
DI void partialSM(f32x16& p0, f32x16& p1, float& m_reg, float& mn, float& alpha) {
    float pmax = p0[0];
#pragma unroll
    for (int r = 1; r < 16; ++r) pmax = fmaxf(pmax, p0[r]);
#pragma unroll
    for (int r = 0; r < 16; ++r) pmax = fmaxf(pmax, p1[r]);
    { auto rr = __builtin_amdgcn_permlane32_swap(__float_as_uint(pmax), __float_as_uint(pmax), false, false);
      pmax = fmaxf(__uint_as_float(rr[0]), __uint_as_float(rr[1])); }
    if (__builtin_expect(__all(pmax - m_reg <= THR2), 1)) { mn = m_reg; alpha = 1.f; }
    else { mn = fmaxf(m_reg, pmax); alpha = ex2(m_reg - mn); m_reg = mn; }
#pragma unroll
    for (int r = 0; r < 16; ++r) { p0[r] -= mn; p1[r] -= mn; }
#pragma unroll
    for (int r = 0; r < 16; ++r) p0[r] = ex2(p0[r]);
}
DI void finishSM(f32x16& p0, f32x16& p1, float alpha, float& l_reg, bf16x8& pa0, bf16x8& pa1, bf16x8& pa2, bf16x8& pa3) {
#pragma unroll
    for (int r = 0; r < 16; ++r) p1[r] = ex2(p1[r]);
    float ps = 0;
#pragma unroll
    for (int r = 0; r < 16; ++r) ps += p0[r];
#pragma unroll
    for (int r = 0; r < 16; ++r) ps += p1[r];
    { auto rr = __builtin_amdgcn_permlane32_swap(__float_as_uint(ps), __float_as_uint(ps), false, false);
      ps = __uint_as_float(rr[0]) + __uint_as_float(rr[1]); }
    l_reg = l_reg * alpha + ps;
#define PK4(P, BASE, OUT) do { unsigned a0 = cvtpk(P[BASE + 0], P[BASE + 1]), a1 = cvtpk(P[BASE + 2], P[BASE + 3]);   \
    unsigned b0 = cvtpk(P[BASE + 4], P[BASE + 5]), b1 = cvtpk(P[BASE + 6], P[BASE + 7]);                              \
    auto r0 = __builtin_amdgcn_permlane32_swap(a0, b0, false, false); auto r1 = __builtin_amdgcn_permlane32_swap(a1, b1, false, false); \
    v4u w = {r0[0], r1[0], r0[1], r1[1]}; OUT = __builtin_bit_cast(bf16x8, w); } while (0)
    PK4(p0, 0, pa0); PK4(p0, 8, pa1); PK4(p1, 0, pa2); PK4(p1, 8, pa3);
#undef PK4
}
template <int DQK> DI void qkt(f32x16& p0, f32x16& p1, const LAS char* Ks, const bf16x8* qr, int r32, int hi) {
    constexpr int KROW = Cfg<DQK>::KROW;
    p0 = f32x16{}; p1 = f32x16{};
#pragma unroll
    for (int d0 = 0; d0 < DQK / 16; ++d0) { const int cb = (d0 * 16 + hi * 8) * 2;
        const bf16x8 b0 = *(const LAS bf16x8*)(Ks + r32 * KROW + cb);
        const bf16x8 b1 = *(const LAS bf16x8*)(Ks + (32 + r32) * KROW + cb);
        p0 = __builtin_amdgcn_mfma_f32_32x32x16_bf16(b0, qr[d0], p0, 0, 0, 0);
        p1 = __builtin_amdgcn_mfma_f32_32x32x16_bf16(b1, qr[d0], p1, 0, 0, 0); }
}
DI int v_st(int k, int c) { const int kk = (k & ~0xC) | ((k & 4) << 1) | ((k & 8) >> 1); return ((kk >> 3) * 4 + (c >> 5)) * 512 + ((kk & 7) * 32 + (c & 31)) * 2; }
DI int v_rd_base(int lane) { return ((lane & 3) << 3) | (((lane >> 2) & 3) << 6) | (((lane >> 4) & 1) << 5) | (((lane >> 5) & 1) << 8); }
constexpr int v_rd_off(int d0, int ks, int half) { return d0 * 512 + ks * 4096 + half * 2048; }
template <int OFF> DI s16x4 tr_read(int vb) { s16x4 r; asm volatile("ds_read_b64_tr_b16 %0, %1 offset:%2" : "=&v"(r) : "v"(vb), "i"(OFF) : "memory"); return r; }
template <int D0> DI void pv_one(f32x16& od, int vb, bf16x8 pa0, bf16x8 pa1, bf16x8 pa2, bf16x8 pa3) {
    const s16x4 l0 = tr_read<v_rd_off(D0, 0, 0)>(vb), h0 = tr_read<v_rd_off(D0, 0, 1)>(vb), l1 = tr_read<v_rd_off(D0, 1, 0)>(vb), h1 = tr_read<v_rd_off(D0, 1, 1)>(vb);
    const s16x4 l2 = tr_read<v_rd_off(D0, 2, 0)>(vb), h2 = tr_read<v_rd_off(D0, 2, 1)>(vb), l3 = tr_read<v_rd_off(D0, 3, 0)>(vb), h3 = tr_read<v_rd_off(D0, 3, 1)>(vb);
    asm volatile("s_waitcnt lgkmcnt(0)" ::: "memory"); SBAR();
#define PK(L, H) (bf16x8){L[0], L[1], L[2], L[3], H[0], H[1], H[2], H[3]}
    od = __builtin_amdgcn_mfma_f32_32x32x16_bf16(pa0, PK(l0, h0), od, 0, 0, 0);
    od = __builtin_amdgcn_mfma_f32_32x32x16_bf16(pa1, PK(l1, h1), od, 0, 0, 0);
    od = __builtin_amdgcn_mfma_f32_32x32x16_bf16(pa2, PK(l2, h2), od, 0, 0, 0);
    od = __builtin_amdgcn_mfma_f32_32x32x16_bf16(pa3, PK(l3, h3), od, 0, 0, 0);
#undef PK
}
DI void pv_d0(f32x16* o, int vb, bf16x8 pa0, bf16x8 pa1, bf16x8 pa2, bf16x8 pa3) {
    pv_one<0>(o[0], vb, pa0, pa1, pa2, pa3); pv_one<1>(o[1], vb, pa0, pa1, pa2, pa3); pv_one<2>(o[2], vb, pa0, pa1, pa2, pa3); pv_one<3>(o[3], vb, pa0, pa1, pa2, pa3);
}
template <int DQK, bool BIAS, int SDEPTH, int LDK, int LDV, bool QFIRST>
DI void attn_pass(LAS char* lds, const bf16* __restrict__ Qw, const bf16* __restrict__ Kh, const bf16* __restrict__ Vh,
                  int NT, int NTw, int bias_from, int bias_idx0, f32x16 (&o)[4], float& l_reg) {
    using C = Cfg<DQK>;
    constexpr int KROW = C::KROW, SHM_K = C::SHM_K, KCH = C::KCH, CPR = C::CPR;
    const int tid = ltid(), wid = __builtin_amdgcn_readfirstlane(tid >> 6), lane = tid & 63, r32 = lane & 31, hi = lane >> 5;
    LAS char* V_lds = lds + C::OFF_V; LAS char* K_lds = lds + C::OFF_K;
    LAS float* wsf = (LAS float*)(lds + C::OFF_WS) + wid * 64; LAS float* al_l = wsf + 32;
    const LAS float* btab = (const LAS float*)(lds + C::OFF_BIAS);
    float m_reg = -1e30f; l_reg = 0.f;
#pragma unroll
    for (int d = 0; d < 4; ++d) o[d] = f32x16{};
    bf16x8 qr[DQK / 16];
#pragma unroll
    for (int d0 = 0; d0 < DQK / 16; ++d0) qr[d0] = *(const bf16x8*)(Qw + d0 * 16);
#define KOFFS() unsigned kso[KCH], kdo[KCH], vso0, vso1; int vst0, vst1; { int t_ = tid; asm volatile("" : "+v"(t_)); const unsigned kr_ = (unsigned)t_ >> 3, kc_ = (unsigned)t_ & 7u; \
        _Pragma("unroll") for (int i_ = 0; i_ < KCH; ++i_) { kso[i_] = (kr_ * LDK + kc_ * 8u) * 2u + i_ * 128u; kdo[i_] = kr_ * KROW + kc_ * 16u + i_ * 128u; } \
        const int sr_i = t_ >> 4, sc_i = (t_ & 15) * 8; vso0 = (unsigned)(sr_i * LDV + sc_i) * 2u; vso1 = (unsigned)((32 + sr_i) * LDV + sc_i) * 2u; vst0 = v_st(sr_i, sc_i); vst1 = v_st(32 + sr_i, sc_i); }
    const int vb0 = (int)(unsigned)(uintptr_t)V_lds + v_rd_base(lane);
    struct { bf16x8 vs0, vs1; bf16x8 ks[KCH]; } sr_[SDEPTH];
#define SLOAD(i, k0) do { KOFFS(); (void)kdo; (void)vst0; (void)vst1; const char* vb_ = (const char*)(Vh + (size_t)(k0) * LDV); const char* kb_ = (const char*)(Kh + (size_t)(k0) * LDK); \
    sr_[i].vs0 = *(const bf16x8*)(vb_ + vso0); sr_[i].vs1 = *(const bf16x8*)(vb_ + vso1); \
    _Pragma("unroll") for (int c_ = 0; c_ < KCH; ++c_) sr_[i].ks[c_] = *(const bf16x8*)(kb_ + kso[c_]); } while (0)
#define SWRITE(b, i) do { KOFFS(); (void)kso; (void)vso0; (void)vso1; *(LAS bf16x8*)(V_lds + (b) * SHM_V + vst0) = sr_[i].vs0; *(LAS bf16x8*)(V_lds + (b) * SHM_V + vst1) = sr_[i].vs1; \
    _Pragma("unroll") for (int c_ = 0; c_ < KCH; ++c_) *(LAS bf16x8*)(K_lds + (b) * SHM_K + kdo[c_]) = sr_[i].ks[c_]; } while (0)
#define SWAIT() do { if constexpr (SDEPTH == 2) { if constexpr (KCH == 1) asm volatile("s_waitcnt vmcnt(3)" ::: "memory"); else asm volatile("s_waitcnt vmcnt(5)" ::: "memory"); } \
    else asm volatile("s_waitcnt vmcnt(0)" ::: "memory"); } while (0)
#define RESC(a) do { if (__any((a) < 1.f)) { if (hi == 0) al_l[r32] = (a); asm volatile("s_waitcnt lgkmcnt(0)" ::: "memory"); \
    _Pragma("unroll") for (int d = 0; d < 4; ++d) _Pragma("unroll") for (int r = 0; r < 16; ++r) o[d][r] *= al_l[crow(r, hi)]; } } while (0)
#define ABIAS(P0, P1, t) do { if (BIAS && (t) >= bias_from) { const LAS float* bp_ = btab + (bias_idx0 + 64 * (t) + 4 * hi); \
    _Pragma("unroll") for (int r = 0; r < 16; ++r) { P0[r] += bp_[(r & 3) + 8 * (r >> 2)]; P1[r] += bp_[32 + (r & 3) + 8 * (r >> 2)]; } } } while (0)
    f32x16 pA0, pA1, pB0, pB1; float mnA, mnB, alA = 1.f, alB = 1.f; bf16x8 pa0, pa1, pa2, pa3;
    static_assert(SDEPTH == 1, "ring version stages one tile in registers");
    int sp = 2, sc = 0, sn = 1;
#define ROT3() do { const int t_ = sp; sp = sc; sc = sn; sn = t_; } while (0)
    __syncthreads();
    SLOAD(0, 0); asm volatile("s_waitcnt vmcnt(0)" ::: "memory"); SWRITE(0, 0);
    SLOAD(0, KVBLK);
    __syncthreads();
    qkt<DQK>(pA0, pA1, K_lds, qr, r32, hi); ABIAS(pA0, pA1, 0); partialSM(pA0, pA1, m_reg, mnA, alA);
    SWRITE(1, 0); if (2 < NT) SLOAD(0, 2 * KVBLK);
    __syncthreads();
    ROT3();
    for (int j = 1; j + 1 < NT; j += 2) {
        const bool aj = j < NTw, ajm = (j - 1) < NTw, ajp = (j + 1) < NTw;
        if constexpr (QFIRST) {
            SBAR(); if (aj) { qkt<DQK>(pB0, pB1, K_lds + sc * SHM_K, qr, r32, hi); ABIAS(pB0, pB1, j); }
            if (ajm) finishSM(pA0, pA1, alA, l_reg, pa0, pa1, pa2, pa3); SBAR();
            if (ajm) pv_d0(o, vb0 + sp * SHM_V, pa0, pa1, pa2, pa3);
        } else {
            SBAR(); if (ajm) finishSM(pA0, pA1, alA, l_reg, pa0, pa1, pa2, pa3); SBAR();
            if (ajm) pv_d0(o, vb0 + sp * SHM_V, pa0, pa1, pa2, pa3);
            SBAR(); if (aj) { qkt<DQK>(pB0, pB1, K_lds + sc * SHM_K, qr, r32, hi); ABIAS(pB0, pB1, j); }
        }
        if (aj) partialSM(pB0, pB1, m_reg, mnB, alB); else alB = 1.f;
        SBAR(); SWRITE(sn, 0); if (j + 2 < NT) SLOAD(0, (j + 2) * KVBLK); SBAR();
        RESC(alB); __syncthreads(); ROT3();
        if constexpr (QFIRST) {
            SBAR(); if (ajp) { qkt<DQK>(pA0, pA1, K_lds + sc * SHM_K, qr, r32, hi); ABIAS(pA0, pA1, j + 1); }
            if (aj) finishSM(pB0, pB1, alB, l_reg, pa0, pa1, pa2, pa3); SBAR();
            if (aj) pv_d0(o, vb0 + sp * SHM_V, pa0, pa1, pa2, pa3);
        } else {
            SBAR(); if (aj) finishSM(pB0, pB1, alB, l_reg, pa0, pa1, pa2, pa3); SBAR();
            if (aj) pv_d0(o, vb0 + sp * SHM_V, pa0, pa1, pa2, pa3);
            SBAR(); if (ajp) { qkt<DQK>(pA0, pA1, K_lds + sc * SHM_K, qr, r32, hi); ABIAS(pA0, pA1, j + 1); }
        }
        if (ajp) partialSM(pA0, pA1, m_reg, mnA, alA); else alA = 1.f;
        SBAR(); if (j + 2 < NT) SWRITE(sn, 0); if (j + 3 < NT) SLOAD(0, (j + 3) * KVBLK); SBAR();
        RESC(alA); __syncthreads(); ROT3();
    }
    { const bool aj = (NT - 1) < NTw, ajm = (NT - 2) < NTw;
      SBAR(); if (aj) { qkt<DQK>(pB0, pB1, K_lds + sc * SHM_K, qr, r32, hi); ABIAS(pB0, pB1, NT - 1); }
      if (ajm) finishSM(pA0, pA1, alA, l_reg, pa0, pa1, pa2, pa3); SBAR();
      if (ajm) pv_d0(o, vb0 + sp * SHM_V, pa0, pa1, pa2, pa3);
      if (aj) partialSM(pB0, pB1, m_reg, mnB, alB); else alB = 1.f;
      RESC(alB);
      if (aj) { finishSM(pB0, pB1, alB, l_reg, pa0, pa1, pa2, pa3); SBAR(); pv_d0(o, vb0 + sc * SHM_V, pa0, pa1, pa2, pa3); } }
#undef ROT3
#undef SLOAD
#undef KOFFS
#undef SWRITE
#undef SWAIT
#undef RESC
#undef ABIAS
}
DI void inv_l(LAS float* wsf, float l_reg, int r32, int hi, float (&rli)[16]) {
    if (hi == 0) wsf[r32] = l_reg; asm volatile("s_waitcnt lgkmcnt(0)" ::: "memory");
#pragma unroll
    for (int r = 0; r < 16; ++r) rli[r] = __builtin_amdgcn_rcpf(wsf[crow(r, hi)]);
    asm volatile("s_waitcnt lgkmcnt(0)" ::: "memory");
}
#ifndef DIFF_SDEPTH
#define DIFF_SDEPTH 1
#endif
#ifndef MLA_SDEPTH
#define MLA_SDEPTH 1
#endif
constexpr int OSTG_ROW = 272, OSTG_WAVE = 32 * OSTG_ROW;
static_assert(NWAVES * OSTG_WAVE <= Cfg<64>::OFF_WS, "the stage overlays the V/K rings only");
DI void ostage_put(LAS char* stg, int row, int col, float v) { *(LAS bf16*)(stg + row * OSTG_ROW + col * 2) = (bf16)(pk2(v, 0.f) & 0xffffu); }
DI void ostage_flush(const LAS char* stg, bf16* Orow0, int lane) {
    asm volatile("s_waitcnt lgkmcnt(0)" ::: "memory");
#pragma unroll
    for (int i = 0; i < 8; ++i) { const int row = 4 * i + (lane >> 4), ch = lane & 15; *(v4u*)(Orow0 + (long)row * D + ch * 8) = *(const LAS v4u*)(stg + row * OSTG_ROW + ch * 16); }
}
DI void mla_unit(LAS char* lds, int b, int h, int qb, const bf16* QM, const bf16* KM, const bf16* VM, bf16* MIX) {
    const int tid = ltid(), wid = __builtin_amdgcn_readfirstlane(tid >> 6), lane = tid & 63, r32 = lane & 31, hi = lane >> 5;
    const long row0 = (long)b * SEQ + qb * 256 + wid * 32;
    const bf16* Qw = QM + (row0 + r32) * UQN + h * 192 + hi * 8;
    const bf16* Kh = KM + (long)b * SEQ * UQN + h * 192; const bf16* Vh = VM + (long)b * SEQ * 768 + h * 128;
    f32x16 o[4]; float l;
#if ATT_STAGGER & 1
    if (wid < 4) attn_pass<192, false, MLA_SDEPTH, UQN, 768, true>(lds, Qw, Kh, Vh, 4 * qb + 4, 4 * qb + (wid >> 1) + 1, 0, 0, o, l);
    else attn_pass<192, false, MLA_SDEPTH, UQN, 768, false>(lds, Qw, Kh, Vh, 4 * qb + 4, 4 * qb + (wid >> 1) + 1, 0, 0, o, l);
#else
    attn_pass<192, false, MLA_SDEPTH, UQN, 768, true>(lds, Qw, Kh, Vh, 4 * qb + 4, 4 * qb + (wid >> 1) + 1, 0, 0, o, l);
#endif
    LAS float* wsf = (LAS float*)(lds + Cfg<192>::OFF_WS) + wid * 64;
    float rli[16]; inv_l(wsf, l, r32, hi, rli);
    int r32b = r32, hib = hi, widb = wid; asm volatile("" : "+v"(r32b), "+v"(hib), "+s"(widb));
    __syncthreads();
    LAS char* stg = lds + widb * OSTG_WAVE;
#pragma unroll
    for (int r = 0; r < 16; ++r) { const int orow = (r & 3) + 8 * (r >> 2) + 4 * hib;
#pragma unroll
        for (int d0 = 0; d0 < 4; ++d0) ostage_put(stg, orow, d0 * 32 + r32b, o[d0][r] * rli[r]); }
    ostage_flush(stg, MIX + row0 * D + MX_ML + h * 128, lane);
}
DI void diff_unit(LAS char* lds, int b, int h, int qb, const bf16* QN, const bf16* KN, const bf16* PROJ, float* scr, bf16* MIX, const float* bias2, float lam, float omli, const float* subln) {
    const int tid = ltid(), wid = __builtin_amdgcn_readfirstlane(tid >> 6), lane = tid & 63, r32 = lane & 31, hi = lane >> 5;
    LAS float* btab = (LAS float*)(lds + Cfg<64>::OFF_BIAS);
    __syncthreads();
    if (tid < 256) btab[tid] = bias2[h * 256 + tid];
    const int q0 = qb * 256, X = q0 + 32 * wid - 153;
    const int bias_from = X <= 0 ? 0 : ((X + 63) >> 6), bias_idx0 = 192 - (q0 + 32 * wid + r32);
    const long row0 = (long)b * SEQ + q0 + wid * 32;
    const bf16* Vh = PROJ + (long)b * SEQ * PINP + C_DV + h * 128;
    LAS float* wsf = (LAS float*)(lds + Cfg<64>::OFF_WS) + wid * 64;
    f32x16 o[4]; float l; float rli[16];
    { const bf16* Qw = QN + (row0 + r32) * 512 + h * 128 + hi * 8; const bf16* Kh = KN + (long)b * SEQ * 512 + h * 128;
#if ATT_STAGGER & 2
      if (wid < 4) attn_pass<64, true, DIFF_SDEPTH, 512, PINP, true>(lds, Qw, Kh, Vh, 4 * qb + 4, 4 * qb + (wid >> 1) + 1, bias_from, bias_idx0, o, l);
      else attn_pass<64, true, DIFF_SDEPTH, 512, PINP, false>(lds, Qw, Kh, Vh, 4 * qb + 4, 4 * qb + (wid >> 1) + 1, bias_from, bias_idx0, o, l);
#else
      attn_pass<64, true, DIFF_SDEPTH, 512, PINP, true>(lds, Qw, Kh, Vh, 4 * qb + 4, 4 * qb + (wid >> 1) + 1, bias_from, bias_idx0, o, l);
#endif
    }
    inv_l(wsf, l, r32, hi, rli);
    int r32b = r32, hib = hi; asm volatile("" : "+v"(r32b), "+v"(hib));
    int tidb = tid; asm volatile("" : "+v"(tidb));
    f32x4* sw4 = (f32x4*)scr + tidb;
#pragma unroll
    for (int r = 0; r < 16; ++r) { sw4[r * NTHREADS] = (f32x4){o[0][r] * rli[r], o[1][r] * rli[r], o[2][r] * rli[r], o[3][r] * rli[r]};
        asm volatile("" ::: "memory"); }
    { const bf16* Qw = QN + (row0 + r32) * 512 + h * 128 + 64 + hi * 8; const bf16* Kh = KN + (long)b * SEQ * 512 + h * 128 + 64;
#if ATT_STAGGER & 2
      if (wid < 4) attn_pass<64, true, DIFF_SDEPTH, 512, PINP, true>(lds, Qw, Kh, Vh, 4 * qb + 4, 4 * qb + (wid >> 1) + 1, bias_from, bias_idx0, o, l);
      else attn_pass<64, true, DIFF_SDEPTH, 512, PINP, false>(lds, Qw, Kh, Vh, 4 * qb + 4, 4 * qb + (wid >> 1) + 1, bias_from, bias_idx0, o, l);
#else
      attn_pass<64, true, DIFF_SDEPTH, 512, PINP, true>(lds, Qw, Kh, Vh, 4 * qb + 4, 4 * qb + (wid >> 1) + 1, bias_from, bias_idx0, o, l);
#endif
    }
    inv_l(wsf, l, r32, hi, rli);
    int widb = wid; asm volatile("" : "+v"(r32b), "+v"(hib), "+v"(tidb), "+s"(widb));
    sw4 = (f32x4*)scr + tidb;
    float sg[4];
#pragma unroll
    for (int d0 = 0; d0 < 4; ++d0) sg[d0] = subln[d0 * 32 + r32b] * omli;
    f32x4 o1v[16];
#pragma unroll
    for (int r = 0; r < 16; ++r) o1v[r] = sw4[r * NTHREADS];
    __syncthreads();
    LAS char* stg = lds + widb * OSTG_WAVE;
#pragma unroll
    for (int r = 0; r < 16; ++r) { const int orow = (r & 3) + 8 * (r >> 2) + 4 * hib; float v[4]; float ss = 0.f;
#pragma unroll
        for (int d0 = 0; d0 < 4; ++d0) { v[d0] = o1v[r][d0] - lam * (o[d0][r] * rli[r]); ss += v[d0] * v[d0]; }
        ss += __shfl_xor(ss, 1); ss += __shfl_xor(ss, 2); ss += __shfl_xor(ss, 4); ss += __shfl_xor(ss, 8); ss += __shfl_xor(ss, 16);
        const float rn = frsqrt(ss * (1.0f / 128.0f) + EPS);
#pragma unroll
        for (int d0 = 0; d0 < 4; ++d0) ostage_put(stg, orow, d0 * 32 + r32b, v[d0] * rn * sg[d0]);
        asm volatile("" ::: "memory"); }
    ostage_flush(stg, MIX + row0 * D + MX_DF + h * 128, lane);
}
#undef SBAR
}

namespace hg {
constexpr int QROW = 272, PROW = 144;
DI void pre_units(LAS char* lds, int u0, int ustride, int nunits, const bf16* PROJ, const float* LF, bf16* QI, bf16* Pm, bf16* KDT, bf16* VT, float* DEC) {
    const int tid = ltid(), tg = __builtin_amdgcn_readfirstlane(tid >> 6), d2 = tid & 63, lane = d2;
    LAS char* qt = lds; LAS char* kt = lds + 64 * QROW; LAS float* tot = (LAS float*)(lds + 2 * 64 * QROW);
    f32x2 lfn[8]; unsigned qn[8], kn[8], vn[8];
#define PLOAD(unit_) do { const int h_ = (unit_) % 6; const long m0_ = (long)((unit_) / 6) * 64; \
    _Pragma("unroll") for (int i = 0; i < 8; ++i) { lfn[i] = *(const f32x2*)(LF + (m0_ + 8 * tg + i) * HGW + h_ * 128 + 2 * d2); \
        const bf16* rp_ = PROJ + (m0_ + 8 * tg + i) * PINP + h_ * 128 + 2 * d2; qn[i] = *(const unsigned*)(rp_ + C_HQ); kn[i] = *(const unsigned*)(rp_ + C_HF); vn[i] = *(const unsigned*)(rp_ + C_HI); } } while (0)
    if (u0 < nunits) PLOAD(u0);
    for (int unit = u0; unit < nunits; unit += ustride) {
    float c0[8], c1[8]; unsigned qw[8], kw[8], vw[8];
    { float a0 = 0.f, a1 = 0.f;
#pragma unroll
      for (int i = 0; i < 8; ++i) { a0 += lfn[i][0]; a1 += lfn[i][1]; c0[i] = a0; c1[i] = a1; qw[i] = qn[i]; kw[i] = kn[i]; vw[i] = vn[i]; }
      tot[tg * 128 + 2 * d2] = a0; tot[tg * 128 + 2 * d2 + 1] = a1; }
    if (unit + ustride < nunits) PLOAD(unit + ustride);
    __syncthreads();
    float pre0 = 0.f, pre1 = 0.f, ref0 = 0.f, ref1 = 0.f, last0 = 0.f, last1 = 0.f;
#pragma unroll
    for (int g = 0; g < 8; ++g) { const float t0 = tot[g * 128 + 2 * d2], t1 = tot[g * 128 + 2 * d2 + 1];
        if (g < tg) { pre0 += t0; pre1 += t1; } if (g < 4) { ref0 += t0; ref1 += t1; } last0 += t0; last1 += t1; }
    unsigned kd0[4], kd1[4], v0[4], v1[4];
    float pkd0 = 0.f, pkd1 = 0.f;
#pragma unroll
    for (int i = 0; i < 8; ++i) { const int t = 8 * tg + i; const float cu0 = pre0 + c0[i], cu1 = pre1 + c1[i];
        const float q0 = bflo(qw[i]), q1 = bfhi(qw[i]), k0 = bflo(kw[i]), k1 = bfhi(kw[i]);
        const float e10 = fexp(fminf(cu0 - ref0, 80.f)), e11 = fexp(fminf(cu1 - ref1, 80.f));
        const float e20 = fexp(fminf(ref0 - cu0, 80.f)), e21 = fexp(fminf(ref1 - cu1, 80.f));
        *(LAS unsigned*)(qt + t * QROW + d2 * 4) = pk2(q0 * e10, q1 * e11);
        *(LAS unsigned*)(kt + t * QROW + d2 * 4) = pk2(k0 * e20, k1 * e21);
        *(unsigned*)(QI + (size_t)unit * 8192 + t * 128 + 2 * d2) = pk2(q0 * fexp(cu0), q1 * fexp(cu1));
        const float kdv0 = k0 * fexp(last0 - cu0), kdv1 = k1 * fexp(last1 - cu1);
        if (i & 1) { kd0[i >> 1] = pk2(pkd0, kdv0); kd1[i >> 1] = pk2(pkd1, kdv1); } else { pkd0 = kdv0; pkd1 = kdv1; }
    }
#pragma unroll
    for (int i = 0; i < 4; ++i) { v0[i] = (vw[2 * i] & 0xffffu) | (vw[2 * i + 1] << 16); v1[i] = (vw[2 * i] >> 16) | (vw[2 * i + 1] & 0xffff0000u); }
    { bf16* kp = KDT + (size_t)unit * 8192 + (2 * d2) * 64 + 8 * tg; *(v4u*)kp = (v4u){kd0[0], kd0[1], kd0[2], kd0[3]}; *(v4u*)(kp + 64) = (v4u){kd1[0], kd1[1], kd1[2], kd1[3]};
      bf16* vp = VT + (size_t)unit * 8192 + (2 * d2) * 64 + 8 * tg; *(v4u*)vp = (v4u){v0[0], v0[1], v0[2], v0[3]}; *(v4u*)(vp + 64) = (v4u){v1[0], v1[1], v1[2], v1[3]}; }
    if (tg == 0) { *(f32x2*)(DEC + (size_t)unit * 128 + 2 * d2) = (f32x2){fexp(last0), fexp(last1)}; }
    __syncthreads();
    { const int tb = tg >> 1, ar = lane & 15, kq = lane >> 4;
#pragma unroll
      for (int sbi = 0; sbi < 2; ++sbi) { const int sb = 2 * (tg & 1) + sbi; f32x4 acc = {0.f, 0.f, 0.f, 0.f};
          if (sb <= tb) {
#pragma unroll
              for (int ks = 0; ks < 4; ++ks) { const bf16x8 a = *(const LAS bf16x8*)(qt + (16 * tb + ar) * QROW + (32 * ks + 8 * kq) * 2);
                  const bf16x8 bb = *(const LAS bf16x8*)(kt + (16 * sb + ar) * QROW + (32 * ks + 8 * kq) * 2); acc = mfma16(a, bb, acc); } }
#pragma unroll
          for (int i = 0; i < 4; ++i) { const int t = 16 * tb + 4 * kq + i, s = 16 * sb + ar; const float v = (s <= t) ? acc[i] : 0.f;
              Pm[(size_t)unit * 4096 + t * 64 + s] = (bf16)(pk2(v, 0.f) & 0xffffu); } } }
    __syncthreads();
    }
#undef PLOAD
}
constexpr int L_QI = 0, L_P = 64 * QROW, L_KD = L_P + 64 * PROW, L_VT = L_KD + 128 * PROW, L_ST = L_VT + 128 * PROW, L_DEC = L_ST + 128 * QROW, L_OG = L_DEC + 512, L_O = L_OG + 512, OROW = 528, L_END = L_O + 64 * OROW;
static_assert(L_END <= RING_BYTES, "hgrn chain LDS map");
DI void chain(LAS char* lds, int b, int h, const bf16* QI, const bf16* Pm, const bf16* KDT, const bf16* VT, const float* DEC, const bf16* PROJ, bf16* MIX, const float* ogain) {
    const int tid = ltid(), w = __builtin_amdgcn_readfirstlane(tid >> 6), lane = tid & 63, ar = lane & 15, kq = lane >> 4;
    const int nt = tid >> 3, nsg = tid & 7;
    __syncthreads();
    for (int i = tid; i < 128 * QROW / 4; i += NTHREADS) ((LAS unsigned*)(lds + L_ST))[i] = 0u;
    f32x4 S[8], ao[4];
#pragma unroll
    for (int db = 0; db < 8; ++db) S[db] = (f32x4){0.f, 0.f, 0.f, 0.f};
#pragma unroll
    for (int tb = 0; tb < 4; ++tb) ao[tb] = (f32x4){0.f, 0.f, 0.f, 0.f};
    if (tid < 128) ((LAS float*)(lds + L_OG))[tid] = ogain[tid];
    v4u rq[2][2], rp[2], rk[2][2], rv[2][2], rgc[2], rgn[2]; f32x4 rdec[2];
    rgc[0] = rgc[1] = rgn[0] = rgn[1] = (v4u){0u, 0u, 0u, 0u};
#pragma unroll
    for (int s_ = 0; s_ < 2; ++s_) rdec[s_] = (f32x4){0.f, 0.f, 0.f, 0.f};
#define HLOAD(c, s) do { const size_t un_ = (size_t)((b * 64 + (c)) * 6 + h); \
    _Pragma("unroll") for (int i_ = 0; i_ < 2; ++i_) { const int ci_ = tid + i_ * NTHREADS; rq[s][i_] = *(const v4u*)(QI + un_ * 8192 + ci_ * 8); rk[s][i_] = *(const v4u*)(KDT + un_ * 8192 + ci_ * 8); rv[s][i_] = *(const v4u*)(VT + un_ * 8192 + ci_ * 8); } \
    rp[s] = *(const v4u*)(Pm + un_ * 4096 + tid * 8); if (tid < 32) rdec[s] = *(const f32x4*)(DEC + un_ * 128 + tid * 4); } while (0)
#define GLOAD(c) do { const bf16* gp_ = PROJ + ((size_t)b * SEQ + (c) * 64 + nt) * PINP + C_HG + h * 128 + 16 * nsg; rgn[0] = *(const v4u*)gp_; rgn[1] = *(const v4u*)(gp_ + 8); } while (0)
    HLOAD(0, 0); HLOAD(1, 1);
#define CBODY(c, s) do { \
        if ((c) < 64) { \
            _Pragma("unroll") for (int i = 0; i < 2; ++i) { const int ci = tid + i * NTHREADS; \
                *(LAS v4u*)(lds + L_QI + (ci >> 4) * QROW + (ci & 15) * 16) = rq[s][i]; \
                *(LAS v4u*)(lds + L_KD + (ci >> 3) * PROW + (ci & 7) * 16) = rk[s][i]; \
                *(LAS v4u*)(lds + L_VT + (ci >> 3) * PROW + (ci & 7) * 16) = rv[s][i]; } \
            *(LAS v4u*)(lds + L_P + (tid >> 3) * PROW + (tid & 7) * 16) = rp[s]; \
            if (tid < 32) *(LAS f32x4*)(lds + L_DEC + tid * 16) = rdec[s]; } \
        if ((c) > 0) { \
            _Pragma("unroll") for (int db = 0; db < 8; ++db) { typedef unsigned u32x2 __attribute__((ext_vector_type(2))); \
                *(LAS u32x2*)(lds + L_ST + (16 * w + ar) * QROW + (16 * db + 4 * kq) * 2) = (u32x2){pk2(S[db][0], S[db][1]), pk2(S[db][2], S[db][3])}; } \
            _Pragma("unroll") for (int tb = 0; tb < 4; ++tb) \
                _Pragma("unroll") for (int i = 0; i < 4; ++i) *(LAS float*)(lds + L_O + (16 * tb + 4 * kq + i) * OROW + (16 * w + ar) * 4) = ao[tb][i]; } \
        __syncthreads();                                               \
        if ((c) + 2 < 64) HLOAD((c) + 2, s); \
        if ((c) < 64) GLOAD(c); \
        if ((c) > 0) {     \
            const long row = (long)b * SEQ + ((c) - 1) * 64 + nt; \
            f32x4 ov[4]; float ss = 0.f; \
            _Pragma("unroll") for (int q = 0; q < 4; ++q) { ov[q] = *(const LAS f32x4*)(lds + L_O + nt * OROW + (16 * nsg + 4 * q) * 4); ss += (ov[q][0] * ov[q][0] + ov[q][1] * ov[q][1]) + (ov[q][2] * ov[q][2] + ov[q][3] * ov[q][3]); } \
            ss += __shfl_xor(ss, 1); ss += __shfl_xor(ss, 2); ss += __shfl_xor(ss, 4); \
            const float rn = frsqrt(ss * (1.0f / 128.0f) + EPS); \
            const unsigned gw[8] = {rgc[0].x, rgc[0].y, rgc[0].z, rgc[0].w, rgc[1].x, rgc[1].y, rgc[1].z, rgc[1].w}; \
            unsigned ow[8]; \
            _Pragma("unroll") for (int q = 0; q < 4; ++q) { const f32x4 gq_ = *(const LAS f32x4*)(lds + L_OG + (16 * nsg + 4 * q) * 4); \
                ow[2 * q] = pk2(ov[q][0] * rn * gq_[0] * bflo(gw[2 * q]), ov[q][1] * rn * gq_[1] * bfhi(gw[2 * q])); \
                ow[2 * q + 1] = pk2(ov[q][2] * rn * gq_[2] * bflo(gw[2 * q + 1]), ov[q][3] * rn * gq_[3] * bfhi(gw[2 * q + 1])); } \
            bf16* op = MIX + row * D + MX_HG + h * 128 + 16 * nsg; \
            *(v4u*)op = (v4u){ow[0], ow[1], ow[2], ow[3]}; *(v4u*)(op + 8) = (v4u){ow[4], ow[5], ow[6], ow[7]}; } \
        if ((c) < 64) { \
            _Pragma("unroll") for (int tb = 0; tb < 4; ++tb) ao[tb] = (f32x4){0.f, 0.f, 0.f, 0.f}; \
            bf16x8 bv[2]; \
            _Pragma("unroll") for (int ks = 0; ks < 4; ++ks) { const bf16x8 bs = *(const LAS bf16x8*)(lds + L_ST + (16 * w + ar) * QROW + (32 * ks + 8 * kq) * 2); \
                _Pragma("unroll") for (int tb = 0; tb < 4; ++tb) { const bf16x8 a = *(const LAS bf16x8*)(lds + L_QI + (16 * tb + ar) * QROW + (32 * ks + 8 * kq) * 2); ao[tb] = mfma16(a, bs, ao[tb]); } __builtin_amdgcn_sched_barrier(0); } \
            _Pragma("unroll") for (int ks = 0; ks < 2; ++ks) { bv[ks] = *(const LAS bf16x8*)(lds + L_VT + (16 * w + ar) * PROW + (32 * ks + 8 * kq) * 2); \
                _Pragma("unroll") for (int tb = 0; tb < 4; ++tb) { const bf16x8 a = *(const LAS bf16x8*)(lds + L_P + (16 * tb + ar) * PROW + (32 * ks + 8 * kq) * 2); ao[tb] = mfma16(a, bv[ks], ao[tb]); } __builtin_amdgcn_sched_barrier(0); } \
            _Pragma("unroll") for (int db = 0; db < 8; ++db) { const f32x4 dc = *(const LAS f32x4*)(lds + L_DEC + (16 * db + 4 * kq) * 4); S[db] = S[db] * dc; \
                _Pragma("unroll") for (int ks = 0; ks < 2; ++ks) { const bf16x8 a = *(const LAS bf16x8*)(lds + L_KD + (16 * db + ar) * PROW + (32 * ks + 8 * kq) * 2); S[db] = mfma16(a, bv[ks], S[db]); } if (db & 1) __builtin_amdgcn_sched_barrier(0); } \
            rgc[0] = rgn[0]; rgc[1] = rgn[1]; \
        } \
        __syncthreads();                                               \
    } while (0)
    for (int c0 = 0; c0 <= 64; c0 += 2) {
        CBODY(c0, 0);
        if (c0 + 1 <= 64) CBODY(c0 + 1, 1);
    }
#undef CBODY
#undef HLOAD
#undef GLOAD
}
}

template <int NB, int KS, int ACOL>
DI void mla_gemm(LAS char* lds, const bf16* __restrict__ Wt, const bf16* __restrict__ PROJ, long m0, int tid, int lane, int ar, int kq, f32x4 (&acc)[2][NB], float (&ssq)[2]) {
    constexpr int CPT = NB / 4, SLOTB = NB * 2 * 1024, NCH = KS / 2;
    v4u sb[CPT], sa[2][2], ac[2][2];
#pragma unroll
    for (int rb = 0; rb < 2; ++rb) { ssq[rb] = 0.f;
#pragma unroll
        for (int nb = 0; nb < NB; ++nb) acc[rb][nb] = (f32x4){0.f, 0.f, 0.f, 0.f}; }
    const bf16* ap = PROJ + (m0 + ar) * PINP + ACOL + 8 * kq;
#define MLOAD(c) do { _Pragma("unroll") for (int i_ = 0; i_ < CPT; ++i_) { const int ci_ = tid + i_ * NTHREADS, blk_ = ci_ >> 6; sb[i_] = *(const v4u*)(Wt + ((size_t)(blk_ >> 1) * KS + 2 * (c) + (blk_ & 1)) * 512 + (ci_ & 63) * 8); } \
    _Pragma("unroll") for (int k_ = 0; k_ < 2; ++k_) _Pragma("unroll") for (int r_ = 0; r_ < 2; ++r_) sa[k_][r_] = *(const v4u*)(ap + (size_t)(16 * r_) * PINP + 32 * (2 * (c) + k_)); } while (0)
#define MWRITE(slot) do { _Pragma("unroll") for (int i_ = 0; i_ < CPT; ++i_) *(LAS v4u*)(lds + (slot) * SLOTB + (tid + i_ * NTHREADS) * 16) = sb[i_]; } while (0)
    __syncthreads();
    MLOAD(0); MWRITE(0);
#pragma unroll
    for (int k = 0; k < 2; ++k)
#pragma unroll
        for (int r = 0; r < 2; ++r) ac[k][r] = sa[k][r];
    __syncthreads();
    for (int c = 0; c < NCH; ++c) {
        if (c + 1 < NCH) MLOAD(c + 1);
        const LAS char* sl = lds + (c & 1) * SLOTB + lane * 16;
#pragma unroll
        for (int k = 0; k < 2; ++k) {
#pragma unroll
            for (int r = 0; r < 2; ++r) { const v4u aw = ac[k][r];
                ssq[r] += (bflo(aw.x) * bflo(aw.x) + bfhi(aw.x) * bfhi(aw.x)) + (bflo(aw.y) * bflo(aw.y) + bfhi(aw.y) * bfhi(aw.y)) + (bflo(aw.z) * bflo(aw.z) + bfhi(aw.z) * bfhi(aw.z)) + (bflo(aw.w) * bflo(aw.w) + bfhi(aw.w) * bfhi(aw.w)); }
#pragma unroll
            for (int nb = 0; nb < NB; ++nb) { const bf16x8 bb = *(const LAS bf16x8*)(sl + (nb * 2 + k) * 1024);
                acc[0][nb] = mfma16(__builtin_bit_cast(bf16x8, ac[k][0]), bb, acc[0][nb]); acc[1][nb] = mfma16(__builtin_bit_cast(bf16x8, ac[k][1]), bb, acc[1][nb]);
                if ((nb & 3) == 3) __builtin_amdgcn_sched_barrier(0); } }
        if (c + 1 < NCH) { MWRITE((c + 1) & 1);
#pragma unroll
            for (int k = 0; k < 2; ++k)
#pragma unroll
                for (int r = 0; r < 2; ++r) ac[k][r] = sa[k][r]; }
        __syncthreads();
    }
#undef MLOAD
#undef MWRITE
#pragma unroll
    for (int rb = 0; rb < 2; ++rb) { ssq[rb] += __shfl_xor(ssq[rb], 16); ssq[rb] += __shfl_xor(ssq[rb], 32); }
}
template <int NB, int KS, int ACOL>
DI void mla_gemm_deep(LAS char* lds, const bf16* __restrict__ Wt, const bf16* __restrict__ PROJ, long m0, int tid, int lane, int ar, int kq, f32x4 (&acc)[2][NB], float (&ssq)[2]) {
    constexpr int CPT = NB / 4, SLOTB = NB * 2 * 1024, NCH = KS / 2;
    static_assert(NCH % 2 == 0, "the K loop is unrolled by two chunks");
    v4u sb0[CPT], sa0[2][2], sb1[CPT], sa1[2][2], ac[2][2];
#pragma unroll
    for (int rb = 0; rb < 2; ++rb) { ssq[rb] = 0.f;
#pragma unroll
        for (int nb = 0; nb < NB; ++nb) acc[rb][nb] = (f32x4){0.f, 0.f, 0.f, 0.f}; }
    const bf16* ap = PROJ + (m0 + ar) * PINP + ACOL + 8 * kq;
#define MLOAD(c, sb, sa) do { _Pragma("unroll") for (int i_ = 0; i_ < CPT; ++i_) { const int ci_ = tid + i_ * NTHREADS, blk_ = ci_ >> 6; sb[i_] = *(const v4u*)(Wt + ((size_t)(blk_ >> 1) * KS + 2 * (c) + (blk_ & 1)) * 512 + (ci_ & 63) * 8); } \
    _Pragma("unroll") for (int k_ = 0; k_ < 2; ++k_) _Pragma("unroll") for (int r_ = 0; r_ < 2; ++r_) sa[k_][r_] = *(const v4u*)(ap + (size_t)(16 * r_) * PINP + 32 * (2 * (c) + k_)); } while (0)
#define MWRITE(slot, sb) do { _Pragma("unroll") for (int i_ = 0; i_ < CPT; ++i_) *(LAS v4u*)(lds + (slot) * SLOTB + (tid + i_ * NTHREADS) * 16) = sb[i_]; } while (0)
#define MTAKE(sa) do { _Pragma("unroll") for (int k_ = 0; k_ < 2; ++k_) _Pragma("unroll") for (int r_ = 0; r_ < 2; ++r_) ac[k_][r_] = sa[k_][r_]; } while (0)
#define MCOMP(slot) do { const LAS char* sl = lds + (slot) * SLOTB + lane * 16; \
        _Pragma("unroll") for (int k = 0; k < 2; ++k) { \
            _Pragma("unroll") for (int r = 0; r < 2; ++r) { const v4u aw = ac[k][r]; \
                ssq[r] += (bflo(aw.x) * bflo(aw.x) + bfhi(aw.x) * bfhi(aw.x)) + (bflo(aw.y) * bflo(aw.y) + bfhi(aw.y) * bfhi(aw.y)) + (bflo(aw.z) * bflo(aw.z) + bfhi(aw.z) * bfhi(aw.z)) + (bflo(aw.w) * bflo(aw.w) + bfhi(aw.w) * bfhi(aw.w)); } \
            _Pragma("unroll") for (int nb = 0; nb < NB; ++nb) { const bf16x8 bb = *(const LAS bf16x8*)(sl + (nb * 2 + k) * 1024); \
                acc[0][nb] = mfma16(__builtin_bit_cast(bf16x8, ac[k][0]), bb, acc[0][nb]); acc[1][nb] = mfma16(__builtin_bit_cast(bf16x8, ac[k][1]), bb, acc[1][nb]); \
                if ((nb & 3) == 3) __builtin_amdgcn_sched_barrier(0); } } } while (0)
    __syncthreads();
    MLOAD(0, sb0, sa0); MLOAD(1, sb1, sa1);
    MWRITE(0, sb0); MTAKE(sa0);
    __syncthreads();
    for (int c = 0; c < NCH; c += 2) {
        if (c + 2 < NCH) MLOAD(c + 2, sb0, sa0);
        MCOMP(0);
        MWRITE(1, sb1); MTAKE(sa1);
        __syncthreads();
        if (c + 3 < NCH) MLOAD(c + 3, sb1, sa1);
        MCOMP(1);
        if (c + 2 < NCH) { MWRITE(0, sb0); MTAKE(sa0); }
        __syncthreads();
    }
#undef MLOAD
#undef MWRITE
#undef MTAKE
#undef MCOMP
#pragma unroll
    for (int rb = 0; rb < 2; ++rb) { ssq[rb] += __shfl_xor(ssq[rb], 16); ssq[rb] += __shfl_xor(ssq[rb], 32); }
}
DI void wait_vm(int n) {
    switch (n) { case 0: asm volatile("s_waitcnt vmcnt(0)" ::: "memory"); break; case 3: asm volatile("s_waitcnt vmcnt(3)" ::: "memory"); break; case 4: asm volatile("s_waitcnt vmcnt(4)" ::: "memory"); break;
        case 7: asm volatile("s_waitcnt vmcnt(7)" ::: "memory"); break; case 8: asm volatile("s_waitcnt vmcnt(8)" ::: "memory"); break; case 10: asm volatile("s_waitcnt vmcnt(10)" ::: "memory"); break;
        case 11: asm volatile("s_waitcnt vmcnt(11)" ::: "memory"); break; case 12: asm volatile("s_waitcnt vmcnt(12)" ::: "memory"); break; case 14: asm volatile("s_waitcnt vmcnt(14)" ::: "memory"); break;
        case 16: asm volatile("s_waitcnt vmcnt(16)" ::: "memory"); break; default: asm volatile("s_waitcnt vmcnt(0)" ::: "memory"); break; }
}
template <int NB, int KS, int ACOL, int ASETS>
DI void mla_gemm_dma(LAS char* lds, const bf16* __restrict__ Wt, const bf16* __restrict__ PROJ, long m0, int tid, int wid, int lane, int ar, int kq, f32x4 (&acc)[2][NB], f32x4 (&ss4)[2]) {
    constexpr int SLOTB = NB * 2 * 1024, NCH = KS / 2, NFW = NB * 2 / 8, NA = 4;
    static_assert((NB * 2) % 8 == 0 && 4 * SLOTB <= RING_BYTES, "chunk loop shape");
    constexpr int AD = ASETS - 1;
    static_assert(ASETS == 2 || ASETS == 3, "A register sets");
    v4u sa[ASETS][2][2];
#pragma unroll
    for (int rb = 0; rb < 2; ++rb) { ss4[rb] = (f32x4){0.f, 0.f, 0.f, 0.f};
#pragma unroll
        for (int nb = 0; nb < NB; ++nb) acc[rb][nb] = (f32x4){0.f, 0.f, 0.f, 0.f}; }
    unsigned ap0 = (unsigned)(((m0 + ar) * PINP + ACOL + 8 * kq) * 2), ap1 = ap0 + 16u * PINP * 2u;
#define ALD1(dst, ptr, OFFS) asm volatile("global_load_dwordx4 %0, %1, %2 offset:" OFFS : "=&v"(dst) : "v"(ptr), "s"(PROJ) : "memory")
#define ALOAD_AT(c, O0, O1) do { ALD1(sa[(c) % ASETS][0][0], ap0, O0); ALD1(sa[(c) % ASETS][0][1], ap1, O0); ALD1(sa[(c) % ASETS][1][0], ap0, O1); ALD1(sa[(c) % ASETS][1][1], ap1, O1); } while (0)
#define ALOAD(c) do { if constexpr (AD == 2) ALOAD_AT(c, "256", "320"); else ALOAD_AT(c, "128", "192"); } while (0)
#define ATIE(c) asm volatile("" : "+v"(sa[(c) % ASETS][0][0]), "+v"(sa[(c) % ASETS][0][1]), "+v"(sa[(c) % ASETS][1][0]), "+v"(sa[(c) % ASETS][1][1]))
#define BDMA(c) do { _Pragma("unroll") for (int i_ = 0; i_ < NFW; ++i_) { const int blk_ = wid + 8 * i_; \
        __builtin_amdgcn_global_load_lds((const unsigned*)(Wt + ((size_t)(blk_ >> 1) * KS + 2 * (c) + (blk_ & 1)) * 512 + lane * 8), (LAS unsigned*)(lds + ((c) & 3) * SLOTB + blk_ * 1024), 16, 0, 0); } } while (0)
#define DOT2(w, accv) __builtin_amdgcn_fdot2_f32_bf16(__builtin_bit_cast(bf16x2_t, (w)), __builtin_bit_cast(bf16x2_t, (w)), (accv), false)
#define BQLD(c, f, dst) do { _Pragma("unroll") for (int q_ = 0; q_ < 4; ++q_) dst[q_] = *(const LAS bf16x8*)(lds + ((c) & 3) * SLOTB + lane * 16 + ((4 * ((f) % (NB / 4)) + q_) * 2 + (f) / (NB / 4)) * 1024); } while (0)
#define MCOMP(c) do { \
          \
        _Pragma("unroll") for (int k = 0; k < 2; ++k) _Pragma("unroll") for (int r = 0; r < 2; ++r) ss4[r] = mfma16(__builtin_bit_cast(bf16x8, sa[(c) % ASETS][k][r]), __builtin_bit_cast(bf16x8, sa[(c) % ASETS][k][r]), ss4[r]); \
        bf16x8 bq[2][4]; BQLD(c, 0, bq[0]); \
        _Pragma("unroll") for (int f = 0; f < NB / 2; ++f) { const int k = f / (NB / 4), g = f % (NB / 4); \
            if (f + 1 < NB / 2) BQLD(c, f + 1, bq[(f + 1) & 1]); \
            __builtin_amdgcn_sched_barrier(0); \
            _Pragma("unroll") for (int q_ = 0; q_ < 4; ++q_) { const int nb = 4 * g + q_; \
                acc[0][nb] = mfma16(__builtin_bit_cast(bf16x8, sa[(c) % ASETS][k][0]), bq[f & 1][q_], acc[0][nb]); acc[1][nb] = mfma16(__builtin_bit_cast(bf16x8, sa[(c) % ASETS][k][1]), bq[f & 1][q_], acc[1][nb]); } \
            __builtin_amdgcn_sched_barrier(0); } } while (0)
    __syncthreads();
    ALOAD_AT(0, "0", "64"); if constexpr (AD == 2) ALOAD_AT(1, "128", "192"); BDMA(0); BDMA(1); BDMA(2);
    asm volatile("s_waitcnt vmcnt(0)" ::: "memory"); ATIE(0); if constexpr (AD == 2) ATIE(1); __builtin_amdgcn_s_barrier();
#pragma unroll
    for (int c = 0; c < NCH; ++c) {
        if (c + AD < NCH) ALOAD(c + AD);
        if (c + 3 < NCH) BDMA(c + 3);
        __builtin_amdgcn_sched_barrier(0);
        MCOMP(c);
        __builtin_amdgcn_sched_barrier(0);
        ap0 += 128u; ap1 += 128u;
        if (c + 1 < NCH) {
            wait_vm(AD == 2 ? (c >= 1 && c + 2 < NCH ? NFW : 0) + (c + 2 < NCH ? NA : 0) + (c + 3 < NCH ? NFW : 0) : (c + 3 < NCH ? NFW : 0));
            ATIE(c + 1);
            __builtin_amdgcn_s_barrier(); }
    }
#undef ALOAD
#undef ALOAD_AT
#undef ALD1
#undef ATIE
#undef BDMA
#undef BQLD
#undef DOT2
#undef MCOMP
}
constexpr int MSTG_ROW = 400, MSTG_WAVE = 32 * MSTG_ROW;
static_assert(NWAVES * MSTG_WAVE <= RING_BYTES, "MLA output stage");
template <int CH> DI void mstage_flush(const LAS char* stg, bf16* O, int pitch, int lane) {
    asm volatile("s_waitcnt lgkmcnt(0)" ::: "memory");
#pragma unroll
    for (int t = 0; t < 32 * CH / 64; ++t) { const int idx = t * 64 + lane, row = idx / CH, ch = idx % CH; *(v4u*)(O + (long)row * pitch + ch * 8) = *(const LAS v4u*)(stg + row * MSTG_ROW + ch * 16); }
    asm volatile("s_waitcnt lgkmcnt(0)" ::: "memory");
}
DI void mla_prep_unit(LAS char* lds, int u, const bf16* PROJ, const bf16* WUQ, const bf16* WUKV, const f32x2* rope, const float* qg, const float* kg, bf16* QM, bf16* KM, bf16* VM) {
    const int tid = ltid(), wid = __builtin_amdgcn_readfirstlane(tid >> 6), lane = tid & 63, ar = lane & 15, kq = lane >> 4;
    const int rt = u / 12, kind = u % 12; const long m0 = (long)rt * 256 + 32 * wid;
#if defined(PROBE_SEL)
#define MPB(id) do { if (PROBE_SEL == (id) && (int)blockIdx.x == PROBE_WG && ltid() == 0) ((volatile LAS unsigned*)(lds - RING_OFF + MISC_OFF))[4] = (unsigned)__builtin_amdgcn_s_memrealtime(); } while (0)
#define MPE(id) do { if (PROBE_SEL == (id) && (int)blockIdx.x == PROBE_WG && ltid() == 0) ((volatile LAS unsigned*)(lds - RING_OFF + MISC_OFF))[5] += (unsigned)__builtin_amdgcn_s_memrealtime() - ((volatile LAS unsigned*)(lds - RING_OFF + MISC_OFF))[4]; } while (0)
#else
#define MPB(id) do { } while (0)
#define MPE(id) do { } while (0)
#endif
    if (kind < 6) {
        const int h = kind; f32x4 acc[2][12]; f32x4 ssq[2];
        MPB(55); mla_gemm_dma<12, 16, C_CQ, 3>(lds, WUQ + (size_t)(h * 12) * 16 * 512, PROJ, m0, tid, wid, lane, ar, kq, acc, ssq); MPE(55); MPB(56);
        int ar_ = ar, kq_ = kq; asm volatile("" : "+v"(ar_), "+v"(kq_));
        __syncthreads();
        LAS char* stg = lds + wid * MSTG_WAVE;
        float gq[12];
#pragma unroll
        for (int nb = 0; nb < 12; ++nb) gq[nb] = qg[16 * nb + ar_];
        f32x2 csv[2][4][2];
#pragma unroll
        for (int rb = 0; rb < 2; ++rb)
#pragma unroll
            for (int i = 0; i < 4; ++i)
#pragma unroll
                for (int jb = 0; jb < 2; ++jb) csv[rb][i][jb] = rope[(int)((m0 + 16 * rb + 4 * kq_ + i) & (SEQ - 1)) * 32 + 16 * jb + ar_];
#pragma unroll
        for (int rb = 0; rb < 2; ++rb)
#pragma unroll
        for (int i = 0; i < 4; ++i) { const long row = m0 + 16 * rb + 4 * kq_ + i; const float rs = frsqrt(__shfl(ssq[rb][i], 20 * kq_ + i) * (1.0f / 512.0f) + EPS);
            float v[12]; float ss = 0.f;
#pragma unroll
            for (int nb = 0; nb < 12; ++nb) { v[nb] = acc[rb][nb][i] * rs; ss += v[nb] * v[nb]; }
            ss += __shfl_xor(ss, 1); ss += __shfl_xor(ss, 2); ss += __shfl_xor(ss, 4); ss += __shfl_xor(ss, 8);
            const float rn = frsqrt(ss * (1.0f / 192.0f) + EPS);
#pragma unroll
            for (int nb = 0; nb < 12; ++nb) v[nb] = v[nb] * rn * gq[nb];
            const int pos = (int)(row & (SEQ - 1));
#pragma unroll
            for (int jb = 0; jb < 2; ++jb) { const f32x2 cs = csv[rb][i][jb]; const float x1 = v[8 + jb], x2 = v[10 + jb]; v[8 + jb] = x1 * cs[0] - x2 * cs[1]; v[10 + jb] = x2 * cs[0] + x1 * cs[1]; }
#pragma unroll
            for (int nb = 0; nb < 12; ++nb) *(LAS bf16*)(stg + (16 * rb + 4 * kq_ + i) * MSTG_ROW + (16 * nb + ar_) * 2) = (bf16)(pk2(v[nb] * SC_MQ, 0.f) & 0xffffu); }
        mstage_flush<24>(stg, QM + m0 * UQN + h * 192, UQN, lane); MPE(56);
    } else {
        const int h = kind - 6; f32x4 acc[2][16]; f32x4 ssq[2];
        MPB(55); mla_gemm_dma<16, 8, C_CKV, 2>(lds, WUKV + (size_t)(h * 16) * 8 * 512, PROJ, m0, tid, wid, lane, ar, kq, acc, ssq); MPE(55); MPB(56);
        int ar_ = ar, kq_ = kq; asm volatile("" : "+v"(ar_), "+v"(kq_));
        __syncthreads();
        LAS char* stg = lds + wid * MSTG_WAVE;
#pragma unroll
        for (int rb = 0; rb < 2; ++rb)
#pragma unroll
        for (int i = 0; i < 4; ++i) { const float rs = frsqrt(__shfl(ssq[rb][i], 20 * kq_ + i) * (1.0f / 256.0f) + EPS);
#pragma unroll
            for (int nb = 0; nb < 8; ++nb) *(LAS bf16*)(stg + (16 * rb + 4 * kq_ + i) * MSTG_ROW + (16 * nb + ar_) * 2) = (bf16)(pk2(acc[rb][8 + nb][i] * rs, 0.f) & 0xffffu); }
        mstage_flush<16>(stg, VM + m0 * 768 + h * 128, 768, lane);
        float gk[12];
#pragma unroll
        for (int nb = 0; nb < 12; ++nb) gk[nb] = kg[16 * nb + ar_];
        f32x2 csv[2][4][2]; unsigned short krv[2][4][4];
#pragma unroll
        for (int rb = 0; rb < 2; ++rb)
#pragma unroll
            for (int i = 0; i < 4; ++i) { const long row_ = m0 + 16 * rb + 4 * kq_ + i;
#pragma unroll
                for (int jb = 0; jb < 2; ++jb) csv[rb][i][jb] = rope[(int)(row_ & (SEQ - 1)) * 32 + 16 * jb + ar_];
#pragma unroll
                for (int jb = 0; jb < 4; ++jb) krv[rb][i][jb] = PROJ[row_ * PINP + C_KR + 16 * jb + ar_]; }
#pragma unroll
        for (int rb = 0; rb < 2; ++rb)
#pragma unroll
        for (int i = 0; i < 4; ++i) { const long row = m0 + 16 * rb + 4 * kq_ + i; const float rs = frsqrt(__shfl(ssq[rb][i], 20 * kq_ + i) * (1.0f / 256.0f) + EPS);
            float v[12]; float ss = 0.f;
#pragma unroll
            for (int nb = 0; nb < 8; ++nb) { v[nb] = acc[rb][nb][i] * rs; ss += v[nb] * v[nb]; }
#pragma unroll
            for (int jb = 0; jb < 4; ++jb) { v[8 + jb] = bf2f(krv[rb][i][jb]); ss += v[8 + jb] * v[8 + jb]; }
            ss += __shfl_xor(ss, 1); ss += __shfl_xor(ss, 2); ss += __shfl_xor(ss, 4); ss += __shfl_xor(ss, 8);
            const float rn = frsqrt(ss * (1.0f / 192.0f) + EPS);
#pragma unroll
            for (int nb = 0; nb < 12; ++nb) v[nb] = v[nb] * rn * gk[nb];
            const int pos = (int)(row & (SEQ - 1));
#pragma unroll
            for (int jb = 0; jb < 2; ++jb) { const f32x2 cs = csv[rb][i][jb]; const float x1 = v[8 + jb], x2 = v[10 + jb]; v[8 + jb] = x1 * cs[0] - x2 * cs[1]; v[10 + jb] = x2 * cs[0] + x1 * cs[1]; }
#pragma unroll
            for (int nb = 0; nb < 12; ++nb) *(LAS bf16*)(stg + (16 * rb + 4 * kq_ + i) * MSTG_ROW + (16 * nb + ar_) * 2) = (bf16)(pk2(v[nb], 0.f) & 0xffffu); }
        mstage_flush<24>(stg, KM + m0 * UQN + h * 192, UQN, lane); MPE(56);
    }
}
DI void diff_norm_unit(int du, const bf16* PROJ, const float* qg, const float* kg, bf16* QN, bf16* KN) {
    const int tid = ltid(), wid = __builtin_amdgcn_readfirstlane(tid >> 6), lane = tid & 63;
    float gqv[8], gkv[8];
#pragma unroll
    for (int j = 0; j < 8; ++j) { gqv[j] = qg[((8 * lane) & 63) + j] * SC_DQ; gkv[j] = kg[((8 * lane) & 63) + j]; }
    v4u w_[8][2];
#pragma unroll
    for (int i = 0; i < 8; ++i) { const long row = (long)du * 64 + wid * 8 + i;
#pragma unroll
        for (int which = 0; which < 2; ++which) w_[i][which] = *(const v4u*)(PROJ + row * PINP + (which ? C_DK : C_DQ) + 8 * lane); }
#pragma unroll
    for (int i = 0; i < 8; ++i) { const long row = (long)du * 64 + wid * 8 + i;
#pragma unroll
        for (int which = 0; which < 2; ++which) { const v4u w = w_[i][which];
            float v[8] = {bflo(w.x), bfhi(w.x), bflo(w.y), bfhi(w.y), bflo(w.z), bfhi(w.z), bflo(w.w), bfhi(w.w)}; float ss = 0.f;
#pragma unroll
            for (int j = 0; j < 8; ++j) ss += v[j] * v[j];
            ss += __shfl_xor(ss, 1); ss += __shfl_xor(ss, 2); ss += __shfl_xor(ss, 4);
            const float rn = frsqrt(ss * (1.0f / 64.0f) + EPS);
#pragma unroll
            for (int j = 0; j < 8; ++j) v[j] = v[j] * rn * (which ? gkv[j] : gqv[j]);
            *(v4u*)((which ? KN : QN) + row * 512 + 8 * lane) = (v4u){pk2(v[0], v[1]), pk2(v[2], v[3]), pk2(v[4], v[5]), pk2(v[6], v[7])}; } }
}

DI void tr_item(const float* W, int K, int N, const float* gain, bf16* WT, int dst_row0, int k0, int n0, LAS float* scr, int lane, int tiledKS = 0) {
    { const int kk0 = lane >> 3, n4 = (lane & 7) * 4;
#pragma unroll
      for (int i = 0; i < 8; ++i) { const int kk = 8 * i + kk0; f32x4 v = *(const f32x4*)(W + (size_t)(k0 + kk) * N + n0 + n4); if (gain) v = v * gain[k0 + kk];
          LAS float* d = scr + kk * 33 + n4; d[0] = v[0]; d[1] = v[1]; d[2] = v[2]; d[3] = v[3]; } }
    LDS_WAIT(); asm volatile("" ::: "memory");
    const int c = lane & 7;
#pragma unroll
    for (int j = 0; j < 4; ++j) { const int n = (lane >> 3) + 8 * j; const LAS float* s = scr + (8 * c) * 33 + n;
        v4u o; o.x = pk2(s[0 * 33], s[1 * 33]); o.y = pk2(s[2 * 33], s[3 * 33]); o.z = pk2(s[4 * 33], s[5 * 33]); o.w = pk2(s[6 * 33], s[7 * 33]);
        const int nn = dst_row0 + n, kk = k0 + 8 * c;
        const size_t off = tiledKS ? ((((size_t)(nn >> 4) * tiledKS + (kk >> 5)) * 64 + ((kk >> 3) & 3) * 16 + (nn & 15)) * 8) : ((size_t)nn * K + kk);
        *(v4u*)(WT + off) = o; }
    LDS_WAIT(); asm volatile("" ::: "memory");
}
DI int t5_bucket(int rel) {
    const int n = rel < 0 ? -rel : rel; int v;
    if (n < 8) v = n; else if (n < 12) v = 8; else if (n < 16) v = 9; else if (n < 23) v = 10; else if (n < 32) v = 11; else if (n < 46) v = 12; else if (n < 64) v = 13; else if (n < 91) v = 14; else v = 15;
    return (rel > 0 ? 16 : 0) + v;
}

#ifndef REP_HPRE
#define REP_HPRE 1
#endif
#ifndef REP_MPREP
#define REP_MPREP 1
#endif
#ifndef REP_CHAIN
#define REP_CHAIN 1
#endif
#ifndef REP_ATT
#define REP_ATT 1
#endif
#ifndef GEMM_ALIGN_UP
#define GEMM_ALIGN_UP true
#endif
#ifndef GEMM_SP2_RES
#define GEMM_SP2_RES true
#endif
#ifndef GEMM_ALIGN_RES
#define GEMM_ALIGN_RES true
#endif
#ifndef REP_FFNUP
#define REP_FFNUP 1
#endif
#ifndef REP_WIN
#define REP_WIN 1
#endif
#ifndef REP_DOWN
#define REP_DOWN 1
#endif
#ifndef REP_WOUT
#define REP_WOUT 1
#endif
#if defined(REP_EPI)
#define REP_EPI_DIV 2
#else
#define REP_EPI_DIV 1
#endif
#ifndef GROUP_SEAMS
#define GROUP_SEAMS 2
#endif
#ifndef KREV_DOWN
#define KREV_DOWN 1
#endif
#ifndef SPLITK_WIN
#define SPLITK_WIN 0
#endif
static_assert(SPLITK_WIN == 0 || SPLITK_SLABS >= 128, "SPLITK_WIN needs the slab region (SPLITK_SLABS)");
#ifndef PREP_OVERLAP
#define PREP_OVERLAP 1
#endif
#ifndef REP_PRO
#define REP_PRO 1
#endif
#ifndef REP_PREP
#define REP_PREP 1
#endif
#ifndef REP_MIX
#define REP_MIX 1
#endif
struct SameOrder : pg8::StaticOrder { __device__ bool next(int i, pg8::Unit& u) const { pg8::Unit t; if (!pg8::StaticOrder::next(i, t)) return false; return pg8::StaticOrder::next(0, u); } };
struct Args {
    const float* in[28];
    float* out; unsigned char* ws;
    int ph_lo, ph_hi;
};
enum { I_X = 0, I_FA_NORM, I_FA_G, I_FA_U, I_FA_D, I_MIX_NORM, I_WIN, I_WOUT, I_LB, I_HG_ON, I_DQN, I_DKN, I_LQ1, I_LK1, I_LQ2, I_LK2, I_SUBLN, I_RELB, I_QLN, I_WUQ, I_KVLN, I_WUKV, I_MQN, I_MKN, I_FB_NORM, I_FB_G, I_FB_U, I_FB_D };

constexpr int TR_G = (D / 64) * (F / 32), TR_DN = (F / 64) * (D / 32), TR_IN = (D / 64) * (PIN / 32), TR_OUT = (D / 64) * (D / 32), TR_UQ = (512 / 64) * (UQN / 32), TR_UKV = (256 / 64) * (UKVN / 32);
constexpr int TR_LAYER = 6 * TR_G + TR_IN + TR_OUT + TR_UQ + TR_UKV;
static_assert(TR_DN == TR_G, "item counts");


struct TrItem { const float* W; const float* gain; bf16* WT; int K, N, dst_row0, k0, n0, tiledKS; };
DI void tr_decode(const Args& A, unsigned char* ws, int it, TrItem& t) {
    const int l = it / TR_LAYER; int r = it % TR_LAYER; unsigned char* wl = ws + WS_W + (size_t)l * W_LAYER;
    t.tiledKS = 0; t.gain = nullptr;
    if (r < 6 * TR_G) { const int which = r / TR_G; r -= which * TR_G;
        const bool isb = which >= 3; const int kind = which % 3;
        if (kind < 2) { const int nblk = F / 32, kb = r / nblk, nb = r % nblk, n0 = 32 * nb;
            t.W = A.in[(isb ? I_FB_G : I_FA_G) + kind] + (size_t)l * D * F; t.gain = A.in[isb ? I_FB_NORM : I_FA_NORM] + (size_t)l * D; t.K = D; t.N = F;
            t.WT = (bf16*)(wl + (isb ? WO_GUB : WO_GUA)); t.dst_row0 = (n0 >> 7) * 256 + (n0 & 127) + kind * 128; t.k0 = 64 * kb; t.n0 = n0; }
        else { const int nblk = D / 32, kb = r / nblk, nb = r % nblk;
            t.W = A.in[isb ? I_FB_D : I_FA_D] + (size_t)l * F * D; t.K = F; t.N = D; t.WT = (bf16*)(wl + (isb ? WO_DB : WO_DA)); t.dst_row0 = 32 * nb; t.k0 = 64 * kb; t.n0 = 32 * nb; }
        return; }
    r -= 6 * TR_G;
    if (r < TR_IN) { const int nblk = PIN / 32, kb = r / nblk, nb = r % nblk;
        t.W = A.in[I_WIN] + (size_t)l * D * PIN; t.gain = A.in[I_MIX_NORM] + (size_t)l * D; t.K = D; t.N = PIN; t.WT = (bf16*)(wl + WO_IN); t.dst_row0 = 32 * nb; t.k0 = 64 * kb; t.n0 = 32 * nb; return; }
    r -= TR_IN;
    if (r < TR_OUT) { const int nblk = D / 32, kb = r / nblk, nb = r % nblk;
        t.W = A.in[I_WOUT] + (size_t)l * D * D; t.K = D; t.N = D; t.WT = (bf16*)(wl + WO_OUT); t.dst_row0 = 32 * nb; t.k0 = 64 * kb; t.n0 = 32 * nb; return; }
    r -= TR_OUT;
    if (r < TR_UQ) { const int nblk = UQN / 32, kb = r / nblk, nb = r % nblk;
        t.W = A.in[I_WUQ] + (size_t)l * 512 * UQN; t.gain = A.in[I_QLN] + (size_t)l * 512; t.K = 512; t.N = UQN; t.WT = (bf16*)(wl + WO_UQ); t.dst_row0 = 32 * nb; t.k0 = 64 * kb; t.n0 = 32 * nb; t.tiledKS = 16; return; }
    r -= TR_UQ;
    { const int nblk = UKVN / 32, kb = r / nblk, nb = r % nblk;
        t.W = A.in[I_WUKV] + (size_t)l * 256 * UKVN; t.gain = A.in[I_KVLN] + (size_t)l * 256; t.K = 256; t.N = UKVN; t.WT = (bf16*)(wl + WO_UKV); t.dst_row0 = 32 * nb; t.k0 = 64 * kb; t.n0 = 32 * nb; t.tiledKS = 8; }
}
DI void tr_load(const TrItem& t, int lane, f32x4 (&v)[8]) {
    const int kk0 = lane >> 3, n4 = (lane & 7) * 4;
#pragma unroll
    for (int i = 0; i < 8; ++i) { const int kk = 8 * i + kk0; v[i] = *(const f32x4*)(t.W + (size_t)(t.k0 + kk) * t.N + t.n0 + n4); if (t.gain) v[i] = v[i] * t.gain[t.k0 + kk]; }
}
DI void tr_store(const TrItem& t, int lane, LAS float* scr, const f32x4 (&v)[8]) {
    { const int kk0 = lane >> 3, n4 = (lane & 7) * 4;
#pragma unroll
      for (int i = 0; i < 8; ++i) { LAS float* d = scr + (8 * i + kk0) * 33 + n4; d[0] = v[i][0]; d[1] = v[i][1]; d[2] = v[i][2]; d[3] = v[i][3]; } }
    LDS_WAIT(); asm volatile("" ::: "memory");
    const int c = lane & 7;
#pragma unroll
    for (int j = 0; j < 4; ++j) { const int n = (lane >> 3) + 8 * j; const LAS float* s = scr + (8 * c) * 33 + n;
        v4u o; o.x = pk2(s[0 * 33], s[1 * 33]); o.y = pk2(s[2 * 33], s[3 * 33]); o.z = pk2(s[4 * 33], s[5 * 33]); o.w = pk2(s[6 * 33], s[7 * 33]);
        const int nn = t.dst_row0 + n, kk = t.k0 + 8 * c;
        const size_t off = t.tiledKS ? ((((size_t)(nn >> 4) * t.tiledKS + (kk >> 5)) * 64 + ((kk >> 3) & 3) * 16 + (nn & 15)) * 8) : ((size_t)nn * t.K + kk);
        *(v4u*)(t.WT + off) = o; }
    LDS_WAIT(); asm volatile("" ::: "memory");
}

#ifndef GEMM_STAGGER
#define GEMM_STAGGER 0
#endif
#ifndef SEAM_FILL
#define SEAM_FILL 2
#endif
#ifndef FFNUP_FILL
#define FFNUP_FILL 0
#endif
#ifndef MIXTAIL_CONVERT
#define MIXTAIL_CONVERT 1
#endif
constexpr int CVB = 32, CW_CVQ = 36864 + 2048;
#ifndef TAIL_CONVERT
#define TAIL_CONVERT 0
#endif
constexpr int CV_A = 5500, CV_B = 15000, CV_C = 20500;
DI void convert_range(const Args& A, unsigned char* ws, LAS unsigned char* lds, int lo, int hi, int widx, int nwg) {
    const int tid = ltid(), lane = tid & 63, wave = __builtin_amdgcn_readfirstlane(tid >> 6);
    LAS float* scr = (LAS float*)(lds + wave * 16384);
    const int NGW = nwg * NWAVES;
    TrItem cur, nxt; f32x4 va[8], vb[8];
    int it = lo + widx * NWAVES + wave; bool have = it < hi;
    if (have) { tr_decode(A, ws, it, cur); tr_load(cur, lane, va); }
    while (have) {
        const int itn = it + NGW; const bool haven = itn < hi;
        if (haven) { tr_decode(A, ws, itn, nxt); tr_load(nxt, lane, vb); }
        tr_store(cur, lane, scr, va);
        cur = nxt; it = itn; have = haven;
#pragma unroll
        for (int i = 0; i < 8; ++i) va[i] = vb[i];
    }
}

DI void prologue(const Args& A, LAS unsigned char* lds, int G) {
    const int tid = ltid(), lane = tid & 63, wave = __builtin_amdgcn_readfirstlane(tid >> 6);
    unsigned char* ws = A.ws;
    LAS float* scr = (LAS float*)(lds + wave * 16384);
    const int gw = blockIdx.x * NWAVES + wave, NGW = G * NWAVES;
    convert_range(A, ws, (LAS unsigned char*)lds, 0, TR_LAYER, (int)blockIdx.x, G);
    if (!MIXTAIL_CONVERT) for (int l = 1; l < NL; ++l) convert_range(A, ws, (LAS unsigned char*)lds, l * TR_LAYER + ((TAIL_CONVERT && G == 256) ? CV_C : 0), (l + 1) * TR_LAYER, (int)blockIdx.x, G);
    { const int gt = blockIdx.x * NTHREADS + tid, NGT = G * NTHREADS; constexpr int PER = (PINP - PIN) * D / 8;
      for (int i = gt; i < NL * PER; i += NGT) { const int l = i / PER, r = i % PER; *(v4u*)(ws + WS_W + (size_t)l * W_LAYER + WO_IN + (size_t)PIN * D * 2 + (size_t)r * 16) = (v4u){0u, 0u, 0u, 0u}; }
      float* LB = (float*)(ws + WS_CONST + CO_LB); float* LAM = (float*)(ws + WS_CONST + CO_LAM); float* BIAS = (float*)(ws + WS_CONST + CO_BIAS); f32x2* ROPE = (f32x2*)(ws + WS_CONST + CO_ROPE);
      for (int c = gt; c < HGW; c += NGT) { const float* lg = A.in[I_LB]; const float a0 = lg[c], a1 = lg[HGW + c], a2 = lg[2 * HGW + c], a3 = lg[3 * HGW + c];
          const float mx = fmaxf(fmaxf(a0, a1), fmaxf(a2, a3)); const float e0 = expf(a0 - mx), e1 = expf(a1 - mx), e2 = expf(a2 - mx), e3 = expf(a3 - mx); const float inv = 1.0f / (e0 + e1 + e2 + e3);
          const float p0 = e0 * inv, p1 = e1 * inv, p2 = e2 * inv, p3 = e3 * inv; const float c0 = p0, c1 = c0 + p1, c2 = c1 + p2, c3 = c2 + p3;
          LB[c] = c0 - c0; LB[HGW + c] = c1 - c0; LB[2 * HGW + c] = c2 - c0; LB[3 * HGW + c] = c3 - c0; }
      if (gt < NL) { const int l = gt; float s1 = 0.f, s2 = 0.f;
          for (int j = 0; j < 64; ++j) { s1 += A.in[I_LQ1][l * 64 + j] * A.in[I_LK1][l * 64 + j]; s2 += A.in[I_LQ2][l * 64 + j] * A.in[I_LK2][l * 64 + j]; }
          LAM[l] = expf(s1) - expf(s2) + (0.8f - 0.6f * expf(-0.3f * (float)l)); }
      for (int i = gt; i < 4 * 256; i += NGT) { const int h = i >> 8, rel = (i & 255) - 192; const float* rb = A.in[I_RELB];
          BIAS[i] = (rb[t5_bucket(rel) * 4 + h] - rb[15 * 4 + h]) * LOG2E; }
      for (int i = gt; i < SEQ * 32; i += NGT) { const int pos = i >> 5, j = i & 31; const float freq = exp2f(-(float)j * (13.287712379549449f / 32.0f)); const float ang = (float)pos * freq;
          double rev = (double)ang * 0.15915494309189535; rev -= floor(rev); const float rf = (float)rev;
          ROPE[i] = (f32x2){__builtin_amdgcn_cosf(rf), __builtin_amdgcn_sinf(rf)}; }
    }
    { bf16* XB = (bf16*)(ws + WS_XB); bf16* XL = (bf16*)(ws + WS_XL); float* ST = (float*)(ws + WS_STATS);
      for (int m = gw; m < M; m += NGW) { const f32x4* xr = (const f32x4*)(A.in[I_X] + (size_t)m * D) + lane; float s = 0.f;
          typedef unsigned u32x2 __attribute__((ext_vector_type(2)));
#pragma unroll
          for (int j = 0; j < 8; ++j) { const f32x4 v = xr[64 * j]; s += (v[0] * v[0] + v[1] * v[1]) + (v[2] * v[2] + v[3] * v[3]);
              const unsigned h0 = pk2(v[0], v[1]), h1 = pk2(v[2], v[3]);
              *((u32x2*)(XB + (size_t)m * D) + lane + 64 * j) = (u32x2){h0, h1};
              if (RESID_LO) *((u32x2*)(XL + (size_t)m * D) + lane + 64 * j) = (u32x2){pk2(v[0] - bflo(h0), v[1] - bfhi(h0)), pk2(v[2] - bflo(h1), v[3] - bfhi(h1))}; }
          s = wave_sum(s); if (lane < 32) ST[(size_t)m * 32 + lane] = lane == 0 ? s : 0.f; } }
}

constexpr int CW_GRP = 32768;
DI void group_barrier(gu32* ctl, int grp, unsigned& epoch, bool local) {
    asm volatile("s_waitcnt vmcnt(0)" ::: "memory");
    __syncthreads();
    ++epoch;
    if (threadIdx.x == 0) {
        unsigned* cnt = (unsigned*)(ctl + CW_GRP + 64 * grp);
        if (!local) { __builtin_amdgcn_fence(__ATOMIC_RELEASE, "agent");
        asm volatile("s_waitcnt vmcnt(0)" ::: "memory"); }
        __hip_atomic_fetch_add(cnt, 1u, __ATOMIC_RELAXED, __HIP_MEMORY_SCOPE_AGENT);
        const unsigned target = 4u * epoch; unsigned sp_ = 0;
        while (__hip_atomic_load(cnt, __ATOMIC_RELAXED, __HIP_MEMORY_SCOPE_AGENT) < target) { __builtin_amdgcn_s_sleep(1);
            if ((++sp_ & 255u) == 0u) { if (__hip_atomic_load((unsigned*)(ctl + CW_BAR) + XB_TMO, __ATOMIC_RELAXED, __HIP_MEMORY_SCOPE_AGENT)) break;
                if (sp_ > XB_SPIN_CAP) { atomicAdd((unsigned*)(ctl + CW_BAR) + XB_TMO, 1u); break; } } }
        __builtin_amdgcn_fence(__ATOMIC_ACQUIRE, "agent");
        asm volatile("s_waitcnt vmcnt(0)" ::: "memory");
    }
    __syncthreads();
}

DI void group_barrier_fill(gu32* ctl, int grp, unsigned& epoch, volatile LAS unsigned* MISC, const Args& args, unsigned char* ws, LAS unsigned char* lds, gu32* qhead, int item0) {
    asm volatile("s_waitcnt vmcnt(0)" ::: "memory");
    __syncthreads();
    ++epoch;
    gu32* cnt = ctl + CW_GRP + 64 * grp; const unsigned target = 4u * epoch;
    if (threadIdx.x == 0) __hip_atomic_fetch_add(cnt, 1u, __ATOMIC_RELAXED, __HIP_MEMORY_SCOPE_AGENT);
    for (;;) {
        __syncthreads();
        if (threadIdx.x == 0) { unsigned q = 0xffffffffu; if (__hip_atomic_load(cnt, __ATOMIC_RELAXED, __HIP_MEMORY_SCOPE_AGENT) < target) q = __hip_atomic_fetch_add(qhead, 1u, __ATOMIC_RELAXED, __HIP_MEMORY_SCOPE_AGENT); MISC[0] = q; }
        __syncthreads();
        const unsigned q = MISC[0];
        if (q == 0xffffffffu || (int)q * CVB >= TR_LAYER) break;
        const int b0 = (int)q * CVB; convert_range(args, ws, lds, item0 + b0, item0 + (b0 + CVB < TR_LAYER ? b0 + CVB : TR_LAYER), 0, 1);
    }
    if (threadIdx.x == 0) { unsigned sp_ = 0;
        while (__hip_atomic_load(cnt, __ATOMIC_RELAXED, __HIP_MEMORY_SCOPE_AGENT) < target) { __builtin_amdgcn_s_sleep(1);
            if ((++sp_ & 255u) == 0u) { if (__hip_atomic_load(ctl + CW_BAR + XB_TMO, __ATOMIC_RELAXED, __HIP_MEMORY_SCOPE_AGENT)) break;
                if (sp_ > XB_SPIN_CAP) { __hip_atomic_fetch_add(ctl + CW_BAR + XB_TMO, 1u, __ATOMIC_RELAXED, __HIP_MEMORY_SCOPE_AGENT); break; } } }
        __builtin_amdgcn_fence(__ATOMIC_ACQUIRE, "agent");
        asm volatile("s_waitcnt vmcnt(0)" ::: "memory"); }
    __syncthreads();
}

DI void xcd_barrier_fill(const XcdBarrier& b, volatile LAS unsigned* MISC, const Args& args, unsigned char* ws, LAS unsigned char* lds, gu32* ctl, int lq, bool fill) {
    asm volatile("s_waitcnt vmcnt(0)" ::: "memory");
    __syncthreads();
    if (threadIdx.x == 0) {
        unsigned* bar = b.bar;
        __builtin_amdgcn_s_waitcnt(0);
        const unsigned nloc = b.st[0], nx = b.st[1];
        const unsigned old = xb_add(&bar[XB_XSUB(b.x)], 1u);
        const unsigned gen = old / nloc;
        if (old + 1u == (gen + 1u) * nloc) {
            __builtin_amdgcn_fence(__ATOMIC_RELEASE, "agent");
            asm volatile("s_waitcnt vmcnt(0)" ::: "memory");
            const unsigned og = xb_add(&bar[XB_TOP], 1u);
            const unsigned tg = og / nx;
            if (og + 1u == (tg + 1u) * nx) xb_add(&bar[XB_TOPGEN], 1u);
            else XB_SPIN(xb_ld(&bar[XB_TOPGEN]) == tg, bar);
            __builtin_amdgcn_fence(__ATOMIC_ACQUIRE, "agent");
            xb_add(&bar[XB_XGEN(b.x)], 1u);
            asm volatile("s_waitcnt vmcnt(0)" ::: "memory");
            MISC[6] = 0u;
        } else { MISC[6] = 1u; MISC[7] = gen; }
    }
    __syncthreads();
    if (MISC[6] == 1u) {
        const unsigned gen = MISC[7];
        bool more = fill && lq + 1 < NL;
        for (;;) {
            __syncthreads();
            if (threadIdx.x == 0) { unsigned v = 0xfffffffeu;
                if (xb_ld(&b.bar[XB_XGEN(b.x)]) != gen) v = 0xffffffffu;
                else if (more) v = __hip_atomic_fetch_add(ctl + CW_CVQ + 16 * lq, 1u, __ATOMIC_RELAXED, __HIP_MEMORY_SCOPE_AGENT);
                else { XB_SPIN(xb_ld(&b.bar[XB_XGEN(b.x)]) == gen, b.bar); v = 0xffffffffu; }
                MISC[0] = v; }
            __syncthreads();
            const unsigned v = MISC[0];
            if (v == 0xffffffffu) break;
            if ((int)v * CVB >= TR_LAYER) { ++lq; more = lq + 1 < NL; continue; }
            const int b0 = (int)v * CVB, item0 = (lq + 1) * TR_LAYER; convert_range(args, ws, lds, item0 + b0, item0 + (b0 + CVB < TR_LAYER ? b0 + CVB : TR_LAYER), 0, 1);
        }
        if (threadIdx.x == 0) { __builtin_amdgcn_fence(__ATOMIC_ACQUIRE, "agent"); asm volatile("s_waitcnt vmcnt(0)" ::: "memory"); }
        __syncthreads();
    }
}

constexpr int CW_WIN = 40960;
constexpr int CW_MQ = 45056;
struct WinOrder {
    pg8::StaticOrder base; bool grp; gu32* cnt; mutable int ndone;
    __device__ __forceinline__ bool next(int i, pg8::Unit& u) const { const bool r = base.next(i, u);
        if (r && grp) { if (u.pn == 16 || u.pn == 17) u.pn += 4; else if (u.pn == 20 || u.pn == 21) u.pn -= 4; } return r; }
    __device__ __forceinline__ void a_ready(const pg8::Unit&) const {}
    __device__ __forceinline__ void done(const pg8::Unit&) const {
        if (grp && ++ndone == 5) { asm volatile("s_waitcnt vmcnt(0)" ::: "memory"); __builtin_amdgcn_s_barrier();
            if (threadIdx.x == 0) __hip_atomic_fetch_add(cnt, 1u, __ATOMIC_RELAXED, __HIP_MEMORY_SCOPE_AGENT); } }
};
__global__ void __launch_bounds__(NTHREADS, 2) fwd_kernel(Args args) {
    extern __shared__ __attribute__((aligned(16))) unsigned char lds_raw[];
    LAS unsigned char* lds0 = (LAS unsigned char*)lds_raw; LAS unsigned char* lds = lds0 + RING_OFF;
    volatile LAS unsigned* MISC = (volatile LAS unsigned*)(lds0 + MISC_OFF);
    const int tid = threadIdx.x, G = gridDim.x;
    gu32* ctl = (gu32*)(args.ws + WS_CTL);
    for (int u = tid; u < RING_OFF / 4; u += NTHREADS) ((LAS unsigned*)(lds0 + LDSCTL_OFF))[u] = 0u;
    __syncthreads();
    XcdBarrier bar = xcd_barrier_post((unsigned*)(ctl + CW_BAR), MISC + 8);
    const int lo = args.ph_lo, hi = args.ph_hi;
    int ph = 0;
#define IN(k) (lo <= (k) && (k) < hi)
#if defined(PROBE_SEL)
#define PM_B(id) do { if (PROBE_SEL == (id) && (int)blockIdx.x == PROBE_WG && tid == 0) MISC[4] = (unsigned)__builtin_amdgcn_s_memrealtime(); } while (0)
#define PM_E(id) do { if (PROBE_SEL == (id) && (int)blockIdx.x == PROBE_WG && tid == 0) MISC[5] += (unsigned)__builtin_amdgcn_s_memrealtime() - MISC[4]; } while (0)
#else
#define PM_B(id) do { } while (0)
#define PM_E(id) do { } while (0)
#endif
#define SEAM(k) do { if (IN(k) && IN((k) + 1)) { PM_B(1); PM_B(11); xcd_barrier(bar); PM_E(1); PM_E(11); } } while (0)
    unsigned gepoch = 0; const int grp = (int)blockIdx.x & 63;
    int gmode = 0;
    if (GROUP_SEAMS == 2 && tid == 0) __hip_atomic_store(ctl + CW_XCC + blockIdx.x, xb_xcc_id() + 1u, __ATOMIC_RELAXED, __HIP_MEMORY_SCOPE_AGENT);
#define GSEAM(k) do { if (IN(k) && IN((k) + 1)) { PM_B(1); PM_B(12); \
        if (GROUP_SEAMS == 1 && G == 256) group_barrier(ctl, grp, gepoch, false); \
        else if (GROUP_SEAMS == 2 && gmode == 1) group_barrier(ctl, grp, gepoch, true); \
        else { xcd_barrier(bar); \
            if (GROUP_SEAMS == 2 && gmode == 0) { if (tid == 0) MISC[1] = __hip_atomic_load(ctl + CW_NONLOCAL, __ATOMIC_RELAXED, __HIP_MEMORY_SCOPE_AGENT); __syncthreads(); gmode = (MISC[1] == 0u && G == 256) ? 1 : 2; } } PM_E(1); PM_E(12); } } while (0)

#define STAGGER_IN() do { if (GEMM_STAGGER > 0 && gmode == 1) { const unsigned long long t_end_ = __builtin_amdgcn_s_memrealtime() + (unsigned long long)((unsigned)grp * (unsigned)(GEMM_STAGGER * 100) / 64u); \
        while (__builtin_amdgcn_s_memrealtime() < t_end_) __builtin_amdgcn_s_sleep(2); } } while (0)
#define WS_PTRS() const unsigned long long ws_u_ = (unsigned long long)args.ws; unsigned char* ws = (unsigned char*)(GAS unsigned char*)ws_u_; \
    bf16* XB = (bf16*)(ws + WS_XB); bf16* XL = (bf16*)(ws + WS_XL); float* STATS = (float*)(ws + WS_STATS); bf16* HB = (bf16*)(ws + WS_A); bf16* PROJ = (bf16*)(ws + WS_A); float* LF = (float*)(ws + WS_LF); \
    bf16* QI = (bf16*)(ws + WS_QI); bf16* PM = (bf16*)(ws + WS_P); bf16* KDT = (bf16*)(ws + WS_KDT); bf16* VT = (bf16*)(ws + WS_VT); float* DEC = (float*)(ws + WS_DEC); \
    bf16* QM = (bf16*)(ws + WS_QM); bf16* KM = (bf16*)(ws + WS_KM); bf16* VM = (bf16*)(ws + WS_VM); bf16* QN = (bf16*)(ws + WS_QN); bf16* KN = (bf16*)(ws + WS_KN); \
    float* SCR = (float*)(ws + WS_SCR); bf16* MIX = (bf16*)(ws + WS_MIX); \
    const float* LB = (const float*)(ws + WS_CONST + CO_LB); const float* LAM = (const float*)(ws + WS_CONST + CO_LAM); const float* BIAS = (const float*)(ws + WS_CONST + CO_BIAS); const f32x2* ROPE = (const f32x2*)(ws + WS_CONST + CO_ROPE); \
    unsigned char* wl = ws + WS_W + (size_t)l * W_LAYER; \
    (void)XB; (void)XL; (void)STATS; (void)HB; (void)PROJ; (void)LF; (void)QI; (void)PM; (void)KDT; (void)VT; (void)DEC; (void)QM; (void)KM; (void)VM; (void)QN; (void)KN; (void)SCR; (void)MIX; (void)LB; (void)LAM; (void)BIAS; (void)ROPE; (void)wl

#ifndef NO_PRO
    PM_B(8); if (IN(ph)) { for (int rep_ = 0; rep_ < REP_PRO; ++rep_) prologue(args, lds, G); } PM_E(8);
#endif
    PM_B(16); SEAM(ph); PM_E(16); ++ph;
    if (GROUP_SEAMS == 2 && tid == 0 && lo == 0 && hi > 1) {
        bool same = G == 256;
#if defined(FORCE_NONLOCAL)
        same = false;
#endif
        if (same) { const unsigned x0 = __hip_atomic_load(ctl + CW_XCC + grp, __ATOMIC_RELAXED, __HIP_MEMORY_SCOPE_AGENT);
            for (int j = 1; j < 4; ++j) same = same && (__hip_atomic_load(ctl + CW_XCC + grp + 64 * j, __ATOMIC_RELAXED, __HIP_MEMORY_SCOPE_AGENT) == x0) && x0 != 0u; }
        if (!same) __hip_atomic_fetch_or(ctl + CW_NONLOCAL, 1u, __ATOMIC_RELAXED, __HIP_MEMORY_SCOPE_AGENT); }

    for (int s = 0; s < 3 * NL; ++s) {
        const int l = s / 3, kind = s % 3;
        if (kind != 1) {
#ifndef NO_FFN1
            PM_B(2); if (IN(ph)) for (int rf_ = 0; rf_ < REP_FFNUP; ++rf_) { WS_PTRS(); const bf16* Wgu = (const bf16*)(wl + (kind == 0 ? WO_GUA : WO_GUB)); pg8::Gemm g{XB, Wgu, M, NGU, D}; pg8::StaticOrder S; S.init(M, NGU, G, (int)blockIdx.x); EpiSwiGLU E{HB, STATS, {}, -1};
#if defined(PROBE_SAMEUNIT)
                if (rf_ == 1) { SameOrder S2; S2.init(M, NGU, G, (int)blockIdx.x); pg8::gemm_phase<EpiSwiGLU, SameOrder, GEMM_ALIGN_UP, true>(lds, g, S2, E); } else
#endif
                pg8::gemm_phase<EpiSwiGLU, pg8::StaticOrder, GEMM_ALIGN_UP, true>(lds, g, S, E);
                if (TAIL_CONVERT && l + 1 < NL && G == 256 && (int)blockIdx.x >= 192) { const int base = (l + 1) * TR_LAYER; convert_range(args, ws, lds, base + (kind == 0 ? 0 : CV_B), base + (kind == 0 ? CV_A : CV_C), (int)blockIdx.x - 192, 64); } }
#endif
            PM_E(2);
            if (FFNUP_FILL && MIXTAIL_CONVERT && GROUP_SEAMS == 2 && gmode == 1 && l + 1 < NL && ((int)blockIdx.x >> 6) == 3 && IN(ph) && IN(ph + 1))
                group_barrier_fill(ctl, grp, gepoch, MISC, args, args.ws, lds, ctl + CW_CVQ + 16 * l, (l + 1) * TR_LAYER);
            else GSEAM(ph);
            ++ph;
#ifndef NO_FFN2
            PM_B(3); if (IN(ph)) { WS_PTRS(); const bf16* Wdn = (const bf16*)(wl + (kind == 0 ? WO_DA : WO_DB)); pg8::Gemm g{HB, Wdn, M, D, F, HP}; pg8::StaticOrder S; S.init(M, D, G, (int)blockIdx.x); EpiResid E{args.out, XB, XL, STATS, 0.5f, s == 3 * NL - 1};
                pg8::gemm_phase<EpiResid, pg8::StaticOrder, GEMM_ALIGN_RES, GEMM_SP2_RES, KREV_DOWN>(lds, g, S, E); }
#endif
            PM_E(3); GSEAM(ph); ++ph;
        } else {
#ifndef NO_WIN
            PM_B(4); if (IN(ph)) for (int rw_ = 0; rw_ < REP_WIN; ++rw_) { WS_PTRS(); pg8::Gemm g{XB, (const bf16*)(wl + WO_IN), M, PINP, D}; EpiProj E{PROJ, LF, STATS, LB + l * HGW, {}, -1};
#if SPLITK_WIN
                typedef pg8::SplitOrder<PINP / 256, D / 64, SPLITK_WIN, 2, 2> WinOrder;
                { WinOrder S{(int)blockIdx.x, ws + WS_SLAB, ctl + CW_SPL + (l + 12 * rw_) * 192 * 16, ctl + CW_BAR + XB_TMO}; pg8::gemm_phase<EpiProj, WinOrder, true, true, 0, 1>(lds, g, S, E); }
#else
                { WinOrder S; S.base.init(M, PINP, G, (int)blockIdx.x); S.grp = PREP_OVERLAP && gmode == 1 && IN(ph + 1); S.cnt = ctl + CW_WIN + (l * 64 + grp) * 16; S.ndone = 0;
                STAGGER_IN(); pg8::gemm_phase<EpiProj, WinOrder, true, true>(lds, g, S, E); }
#endif
                if (TAIL_CONVERT && l + 1 < NL && G == 256 && (int)blockIdx.x >= 128) { const int base = (l + 1) * TR_LAYER; convert_range(args, ws, lds, base + CV_A, base + CV_B, (int)blockIdx.x - 128, 128); } }
#endif
            PM_E(4);
            const bool pgrp = PREP_OVERLAP && gmode == 1 && IN(ph) && IN(ph + 1);
            if (pgrp) { PM_B(1); PM_B(13); if (tid == 0) { gu32* cnt = ctl + CW_WIN + (l * 64 + grp) * 16; unsigned sp_ = 0;
                    while (__hip_atomic_load(cnt, __ATOMIC_RELAXED, __HIP_MEMORY_SCOPE_AGENT) < 4u) { __builtin_amdgcn_s_sleep(1);
                        if ((++sp_ & 255u) == 0u) { if (__hip_atomic_load(ctl + CW_BAR + XB_TMO, __ATOMIC_RELAXED, __HIP_MEMORY_SCOPE_AGENT)) break;
                            if (sp_ > XB_SPIN_CAP) { __hip_atomic_fetch_add(ctl + CW_BAR + XB_TMO, 1u, __ATOMIC_RELAXED, __HIP_MEMORY_SCOPE_AGENT); break; } } }
                    __builtin_amdgcn_fence(__ATOMIC_ACQUIRE, "agent"); asm volatile("s_waitcnt vmcnt(0)" ::: "memory"); }
                __syncthreads(); PM_E(1); PM_E(13); }
            else SEAM(ph);
            ++ph;
            PM_B(5); if (IN(ph)) { WS_PTRS();
                const int pm_ = 8 * ((int)blockIdx.x & 7) + (((int)blockIdx.x >> 3) & 7), j_ = (int)blockIdx.x >> 6;
#ifndef NO_HPRE
                PM_B(51); { const int u0 = pgrp ? (4 * pm_ + j_) * 6 : (int)blockIdx.x; hg::pre_units((LAS char*)lds, u0, pgrp ? 1 : G, pgrp ? u0 + 6 : 1536, PROJ, LF, QI, PM, KDT, VT, DEC); } PM_E(51);
#endif
#ifndef NO_DNORM
                PM_B(52); { const int d0 = pgrp ? 4 * pm_ + j_ : (int)blockIdx.x, d1 = pgrp ? d0 + 1 : 256; for (int u = d0; u < d1; u += G) diff_norm_unit(u, PROJ, args.in[I_DQN] + l * 64, args.in[I_DKN] + l * 64, QN, KN); } PM_E(52);
#endif
#ifndef NO_MPREP
                PM_B(53);
                for (int k_ = 0;; ++k_) { int u;
                    if (pgrp) { __syncthreads();
                        if (tid == 0) MISC[0] = __hip_atomic_fetch_add(ctl + CW_MQ + (l * 64 + grp) * 16, 1u, __ATOMIC_RELAXED, __HIP_MEMORY_SCOPE_AGENT);
                        __syncthreads();
                        const int q = (int)MISC[0]; if (q >= 12) break; u = pm_ * 12 + q; }
                    else { u = (int)blockIdx.x + k_ * G; if (u >= 768) break; }
#if defined(PROBE_SEL)
                    if (PROBE_SEL == 54 && (int)blockIdx.x == PROBE_WG && tid == 0) MISC[5] += 1000u;
#endif
                    mla_prep_unit((LAS char*)lds, u, PROJ, (const bf16*)(wl + WO_UQ), (const bf16*)(wl + WO_UKV), ROPE, args.in[I_MQN] + l * 192, args.in[I_MKN] + l * 192, QM, KM, VM); }
                PM_E(53);
#endif
            }
            PM_E(5); PM_B(14);
            if (SEAM_FILL && MIXTAIL_CONVERT && IN(ph) && IN(ph + 1) && l + 1 < NL && G > 24) { PM_B(1); xcd_barrier_fill(bar, MISC, args, args.ws, lds, ctl, l, (int)blockIdx.x >= 24); PM_E(1); }
            else SEAM(ph);
            PM_E(14); ++ph;
            PM_B(6); if (IN(ph)) for (int rep_ = 0; rep_ < REP_MIX; ++rep_) { WS_PTRS();
#ifndef NO_CHAIN
                if (blockIdx.x < 24) for (int rc_ = 0; rc_ < REP_CHAIN; ++rc_) hg::chain((LAS char*)lds, blockIdx.x / 6, blockIdx.x % 6, QI, PM, KDT, VT, DEC, PROJ, MIX, args.in[I_HG_ON] + l * 128);
#endif
                const float lam = LAM[l], omli = 1.0f - (0.8f - 0.6f * expf(-0.3f * (float)l));
                { bool att_left = true, cv_left = MIXTAIL_CONVERT && l + 1 < NL && rep_ == 0;
                  for (;;) {
                    __syncthreads();
                    if (tid == 0) { MISC[0] = att_left ? __hip_atomic_fetch_add((unsigned*)(ctl + CW_Q + 64 * (l + 4 * rep_)), 1u, __ATOMIC_RELAXED, __HIP_MEMORY_SCOPE_AGENT) : 640u;
                        MISC[2] = (cv_left && (MIXTAIL_CONVERT == 2 || !att_left)) ? __hip_atomic_fetch_add(ctl + CW_CVQ + 16 * l, 1u, __ATOMIC_RELAXED, __HIP_MEMORY_SCOPE_AGENT) : 0xffffffffu; }
                    __syncthreads();
                    const int u = (int)MISC[0]; const unsigned bq = MISC[2];
                    att_left = u < 640;
                    const bool cv_now = bq != 0xffffffffu && (int)bq * CVB < TR_LAYER;
                    if (bq != 0xffffffffu && !cv_now) cv_left = false;
                    if (!att_left && !cv_left) break;
                    if (att_left) { const int qb = 15 - u / 40, r = u % 40;
#ifndef NO_DIFF
                        if (r < 16) att::diff_unit((LAS char*)lds, r >> 2, r & 3, qb, QN, KN, PROJ, SCR + (size_t)blockIdx.x * 256 * 128, MIX, BIAS, lam, omli, args.in[I_SUBLN] + l * 128);
#endif
#ifndef NO_MLA
                        if (r >= 16) att::mla_unit((LAS char*)lds, (r - 16) / 6, (r - 16) % 6, qb, QM, KM, VM, MIX);
#endif
                    }
                    if (cv_now) { const int b0 = (int)bq * CVB; const int lo_ = (l + 1) * TR_LAYER + b0, hi_ = (l + 1) * TR_LAYER + (b0 + CVB < TR_LAYER ? b0 + CVB : TR_LAYER);
                        __syncthreads();
                        convert_range(args, ws, lds, lo_, hi_, 0, 1); }
                  } }
            }
            PM_E(6); PM_B(15);
            if (SEAM_FILL >= 2 && MIXTAIL_CONVERT && IN(ph) && IN(ph + 1) && l + 2 < NL) { PM_B(1); xcd_barrier_fill(bar, MISC, args, args.ws, lds, ctl, l + 1, true); PM_E(1); }
            else SEAM(ph);
            PM_E(15); ++ph;
#ifndef NO_WOUT
            PM_B(7); if (IN(ph)) { WS_PTRS(); pg8::Gemm g{MIX, (const bf16*)(wl + WO_OUT), M, D, D}; pg8::StaticOrder S; S.init(M, D, G, (int)blockIdx.x); EpiResid E{args.out, XB, XL, STATS, 1.0f, false};
                STAGGER_IN(); pg8::gemm_phase<EpiResid, pg8::StaticOrder, GEMM_ALIGN_RES, GEMM_SP2_RES>(lds, g, S, E); }
#endif
            PM_E(7); GSEAM(ph); ++ph;
        }
    }
#if defined(PROBE_SEL)
    if ((int)blockIdx.x == PROBE_WG && tid == 0) { const unsigned long long t_end_ = __builtin_amdgcn_s_memrealtime() + (unsigned long long)MISC[5] * PROBE_SCALE;
        while (__builtin_amdgcn_s_memrealtime() < t_end_) __builtin_amdgcn_s_sleep(8); }
#endif
#undef IN
#undef SEAM
}
constexpr int N_PHASES = 1 + NL * (2 + 4 + 2);

#ifndef MK_MULTI
#define MK_MULTI 0
#endif
extern "C" void kernel_launch(void* const* d_in, const int* in_sizes, int n_in, void* d_out, int out_size, void* d_ws, size_t ws_size, hipStream_t stream) {
    static int grid = 0;
    if (grid == 0) {
        if (n_in != 28 || in_sizes[0] != M * D || out_size != M * D || ws_size < WS_END) { fprintf(stderr, "kernel_launch: shape mismatch: n_in %d in0 %d out %d ws %zu (need %zu)\n", n_in, n_in > 0 ? in_sizes[0] : -1, out_size, ws_size, (size_t)WS_END); grid = -1; return; }
        int dev = 0, cus = 0, per_cu = 0;
        if (hipGetDevice(&dev) != hipSuccess || hipDeviceGetAttribute(&cus, hipDeviceAttributeMultiprocessorCount, dev) != hipSuccess) { fprintf(stderr, "kernel_launch: device query failed\n"); grid = -1; return; }
        if (hipFuncSetAttribute((const void*)fwd_kernel, hipFuncAttributeMaxDynamicSharedMemorySize, LDS_BYTES) != hipSuccess) { fprintf(stderr, "kernel_launch: hipFuncSetAttribute failed\n"); grid = -1; return; }
        if (hipOccupancyMaxActiveBlocksPerMultiprocessor(&per_cu, (const void*)fwd_kernel, NTHREADS, LDS_BYTES) != hipSuccess || per_cu < 1) fprintf(stderr, "kernel_launch: note: occupancy query reports %d workgroups per CU\n", per_cu);
        (void)hipGetLastError();
        grid = cus;
    }
    if (grid < 0) return;
    if (hipMemsetAsync((char*)d_ws + WS_CTL, 0, CTL_ZERO_BYTES, stream) != hipSuccess) { fprintf(stderr, "kernel_launch: memset failed\n"); return; }
    Args a{};
    for (int i = 0; i < 28; ++i) a.in[i] = (const float*)d_in[i];
    a.out = (float*)d_out; a.ws = (unsigned char*)d_ws;
#if MK_MULTI
    for (int p = 0; p < N_PHASES; ++p) { a.ph_lo = p; a.ph_hi = p + 1; hipLaunchKernelGGL(fwd_kernel, dim3(grid), dim3(NTHREADS), LDS_BYTES, stream, a); }
#else
    a.ph_lo = 0; a.ph_hi = N_PHASES;
    hipLaunchKernelGGL(fwd_kernel, dim3(grid), dim3(NTHREADS), LDS_BYTES, stream, a);
#endif
    const hipError_t le = hipPeekAtLastError();
    if (le != hipSuccess) fprintf(stderr, "kernel_launch: launch failed: %s\n", hipGetErrorName(le));
}
```
